# Optimizing an MI355X kernel written in HIP

```python
import math
import jax
import jax.numpy as jnp
from jax import lax
import numpy as np

D_MODEL = 1024
BATCH = 8
SEQ = 2048
DEPTH = 2
DEC_BATCH = 128
DEC_SEQ = 8
PAST_LEN = 16384
PAGE_SIZE = 128

GROUP_WIDTH = D_MODEL // 4
HEAD_DIM = 64
N_MIX_HEADS = GROUP_WIDTH // HEAD_DIM
S5_CH = GROUP_WIDTH
S5_GROUP = 16
S5_NGROUPS = S5_CH // S5_GROUP
S5_STATE = 64
S5_STEP_MIN = 1e-3
S5_STEP_MAX = 1e-1
HG_CHUNK = 16
RET_CHUNK = 64
ROPE_BASE = 10000.0
RW_W_RANK = 64
RW_A_RANK = 64
RW_G_RANK = 128
RW_PROJ = 3 * GROUP_WIDTH + RW_W_RANK + RW_A_RANK + RW_G_RANK
HG_COLS = 4 * GROUP_WIDTH
RET_COLS = 4 * GROUP_WIDTH
IN_WIDTH = S5_CH + HG_COLS + RET_COLS + RW_PROJ
MEM_LEN = 256
MEM_HEADS = 4
MEM_HEAD_DIM = D_MODEL // MEM_HEADS
D_FF = 4 * D_MODEL
EPS = 1e-6
RW_LN_EPS = 64e-5

kernel_name = 'hymba_s5_hgrn2_retnet_rwkv7_step'


def rmsnorm(x, gain):
    xf = x.astype(jnp.float32)
    return xf * lax.rsqrt(jnp.mean(xf * xf, axis=-1, keepdims=True) + EPS) * gain.astype(jnp.float32)


def to_heads(t):
    b, l, _ = t.shape
    return t.reshape(b, l, N_MIX_HEADS, HEAD_DIM).transpose(0, 2, 1, 3)


def from_heads(t):
    b, h, l, d = t.shape
    return t.transpose(0, 2, 1, 3).reshape(b, l, h * d)


def head_rms(t):
    return t * lax.rsqrt(jnp.mean(t * t, axis=-1, keepdims=True) + EPS)


def rope(x, pos):
    half = HEAD_DIM // 2
    inv = ROPE_BASE ** (-jnp.arange(half, dtype=jnp.float32) / half)
    ang = pos.astype(jnp.float32)[:, None] * inv[None, :]
    cos, sin = jnp.cos(ang), jnp.sin(ang)
    x1, x2 = x[..., :half], x[..., half:]
    return jnp.concatenate([x1 * cos - x2 * sin, x1 * sin + x2 * cos], axis=-1)


def _diag_combine(e1, e2):
    a1, b1 = e1
    a2, b2 = e2
    return a1 * a2, a2 * b1 + b2


def s5_mixer(u, lam_re, lam_im, b_re, b_im, c_re, c_im, d_skip, log_step, w_glu, b_glu, gain, h0_re, h0_im):
    f32 = jnp.float32
    bsz, seq, _ = u.shape
    uf = u.astype(f32).reshape(bsz, seq, S5_NGROUPS, S5_GROUP)
    lam = lax.complex(lam_re.astype(f32), lam_im.astype(f32))
    step = jnp.exp(log_step.astype(f32))[:, None]
    lam_bar = jnp.exp(lam * step)
    b_mat = lax.complex(b_re.astype(f32), b_im.astype(f32))
    b_bar = ((lam_bar - 1.0) / lam)[..., None] * b_mat
    bu = jnp.einsum('gph,blgh->blgp', b_bar, uf)
    h0 = lax.complex(h0_re.astype(f32), h0_im.astype(f32))
    bu = bu.at[:, 0].add(lam_bar * h0)
    a = jnp.broadcast_to(lam_bar, bu.shape)
    _, h = lax.associative_scan(_diag_combine, (a, bu), axis=1)
    c_mat = lax.complex(c_re.astype(f32), c_im.astype(f32))
    y = jnp.real(jnp.einsum('ghp,blgp->blgh', c_mat, h)) + d_skip.astype(f32) * uf
    y = jax.nn.gelu(y.reshape(bsz, seq, S5_CH))
    y = y * jax.nn.sigmoid(y @ w_glu + b_glu)
    h_last = h[:, -1]
    return rmsnorm(y, gain), jnp.real(h_last), jnp.imag(h_last)


def chunked_gated_recurrence(q, k, v, log_f, s0, chunk):
    b, h, l, dk = q.shape
    dv = v.shape[-1]
    n = l // chunk
    q = q.reshape(b, h, n, chunk, dk)
    k = k.reshape(b, h, n, chunk, dk)
    v = v.reshape(b, h, n, chunk, dv)
    cum = jnp.cumsum(log_f.reshape(b, h, n, chunk, dk), axis=3)
    causal = jnp.tril(jnp.ones((chunk, chunk), dtype=bool))[:, :, None]
    diff = cum[:, :, :, :, None, :] - cum[:, :, :, None, :, :]
    decay = jnp.exp(jnp.where(causal, diff, -jnp.inf))
    scores = jnp.einsum('bhntd,bhnsd,bhntsd->bhnts', q, k, decay)
    o_intra = jnp.einsum('bhnts,bhnsv->bhntv', scores, v)
    last = cum[:, :, :, -1:, :]
    delta = jnp.einsum('bhncd,bhncv->bhndv', k * jnp.exp(last - cum), v)
    g_chunk = jnp.exp(last[:, :, :, 0, :])

    def step(s, inp):
        g, dlt = inp
        return g[..., None] * s + dlt, s

    s_fin, s_start = lax.scan(step, s0, (jnp.moveaxis(g_chunk, 2, 0), jnp.moveaxis(delta, 2, 0)))
    o_inter = jnp.einsum('bhntd,nbhdv->bhntv', q * jnp.exp(cum), s_start)
    return (o_intra + o_inter).reshape(b, h, l, dv), s_fin


def hgrn2_mixer(q_pre, f_pre, i_in, g_pre, lb, gain, s0):
    f32 = jnp.float32
    zf = f_pre.astype(f32)
    lbf = lb.astype(f32)
    log_f = jnp.logaddexp(jax.nn.log_sigmoid(zf), jnp.log(lbf) + jax.nn.log_sigmoid(-zf))
    key = (1.0 - lbf) * jax.nn.sigmoid(-zf)
    q = jax.nn.silu(q_pre.astype(f32))
    seq = q_pre.shape[1]
    o, s = chunked_gated_recurrence(to_heads(q), to_heads(key), to_heads(i_in.astype(f32)),
                                    to_heads(log_f), s0.astype(f32), math.gcd(seq, HG_CHUNK))
    o = from_heads(head_rms(o)) * gain.astype(f32)
    return o * jax.nn.silu(g_pre.astype(f32)), s


def retention_mixer(q_pre, k_pre, v_pre, g_pre, pos, s0):
    f32 = jnp.float32
    bsz, seq, _ = q_pre.shape
    chunk = math.gcd(seq, RET_CHUNK)
    n = seq // chunk
    q = rope(to_heads(q_pre.astype(f32)), pos)
    k = rope(to_heads(k_pre.astype(f32)), pos) * HEAD_DIM ** -0.5
    v = to_heads(v_pre.astype(f32))
    log_gamma = jnp.log(1.0 - 2.0 ** (-5.0 - jnp.arange(N_MIX_HEADS, dtype=f32)))
    q = q.reshape(bsz, N_MIX_HEADS, n, chunk, HEAD_DIM)
    k = k.reshape(bsz, N_MIX_HEADS, n, chunk, HEAD_DIM)
    v = v.reshape(bsz, N_MIX_HEADS, n, chunk, HEAD_DIM)
    idx = jnp.arange(chunk, dtype=f32)
    rel = idx[:, None] - idx[None, :]
    dmat = jnp.where(rel >= 0, jnp.exp(log_gamma[:, None, None] * jnp.maximum(rel, 0.0)), 0.0)
    scores = jnp.einsum('bhntd,bhnsd->bhnts', q, k) * dmat[None, :, None]
    o_intra = jnp.einsum('bhnts,bhnsv->bhntv', scores, v)
    k_tail = k * jnp.exp(log_gamma[:, None] * (chunk - 1.0 - idx))[None, :, None, :, None]
    delta = jnp.einsum('bhncd,bhncv->bhndv', k_tail, v)
    g_chunk = jnp.exp(log_gamma * chunk)[None, :, None, None]

    def step(s, dlt):
        return g_chunk * s + dlt, s

    s_fin, s_start = lax.scan(step, s0.astype(f32), jnp.moveaxis(delta, 2, 0))
    o_inter = jnp.einsum('bhntd,nbhdv->bhntv', q, s_start) * jnp.exp(log_gamma[:, None] * (idx + 1.0))[None, :, None, :, None]
    o = (o_intra + o_inter).reshape(bsz, N_MIX_HEADS, seq, HEAD_DIM)
    return from_heads(head_rms(o)) * jax.nn.silu(g_pre.astype(f32)), s_fin


def rwkv7_mixer(proj, shift0, mu, w0, w_w2, a0, w_a2, w_g2, k_k, k_a, r_k, ln_g, ln_b, s0):
    f32 = jnp.float32
    pf = proj.astype(f32)
    bsz, seq, _ = pf.shape
    prev = jnp.concatenate([shift0.astype(f32)[:, None], pf[:, :-1]], axis=1)
    pm = pf + (prev - pf) * mu.astype(f32)
    gw = GROUP_WIDTH
    r, k, v = pm[..., :gw], pm[..., gw:2 * gw], pm[..., 2 * gw:3 * gw]
    o = 3 * gw
    w_lr = pm[..., o:o + RW_W_RANK]
    a_lr = pm[..., o + RW_W_RANK:o + RW_W_RANK + RW_A_RANK]
    g_lr = pm[..., o + RW_W_RANK + RW_A_RANK:]
    log_w = -jax.nn.softplus(-(w0 + jnp.tanh(w_lr) @ w_w2)) - 0.5
    decay = jnp.exp(-jnp.exp(log_w))
    iclr = jax.nn.sigmoid(a0 + a_lr @ w_a2)
    gate = jax.nn.sigmoid(g_lr) @ w_g2

    def hd(t):
        return t.reshape(bsz, seq, N_MIX_HEADS, HEAD_DIM)

    kk = hd(k * k_k)
    kk = kk / jnp.maximum(jnp.linalg.norm(kk, axis=-1, keepdims=True), 1e-12)
    k = k * (1.0 + (iclr - 1.0) * k_a)
    r_h, k_h, v_h, w_h, a_h = hd(r), hd(k), hd(v), hd(decay), hd(iclr)

    def tm(t):
        return jnp.swapaxes(t, 0, 1)

    def step(s, inp):
        r_t, w_t, k_t, v_t, kk_t, a_t = inp
        sa = jnp.einsum('bhvk,bhk->bhv', s, -kk_t)
        s = s * w_t[:, :, None, :] + sa[..., None] * (kk_t * a_t)[:, :, None, :] + v_t[..., None] * k_t[:, :, None, :]
        return s, jnp.einsum('bhvk,bhk->bhv', s, r_t)

    s_fin, y = lax.scan(step, s0.astype(f32), (tm(r_h), tm(w_h), tm(k_h), tm(v_h), tm(kk), tm(a_h)))
    y = tm(y)
    mean = jnp.mean(y, axis=-1, keepdims=True)
    var = jnp.mean(jnp.square(y - mean), axis=-1, keepdims=True)
    y = ((y - mean) * lax.rsqrt(var + RW_LN_EPS)).reshape(bsz, seq, gw) * ln_g + ln_b
    bonus = jnp.sum(r_h * k_h * r_k.reshape(N_MIX_HEADS, HEAD_DIM), axis=-1, keepdims=True) * v_h
    y = (y + bonus.reshape(bsz, seq, gw)) * gate
    return y, s_fin, pf[:, -1]


def memory_kv(mem, w_k, w_v):
    b, m, _ = mem.shape
    k = (mem @ w_k).reshape(b, m, MEM_HEADS, MEM_HEAD_DIM)
    v = (mem @ w_v).reshape(b, m, MEM_HEADS, MEM_HEAD_DIM)
    return k, v


def cross_attend(h, mem_k, mem_v, w_q, w_o):
    b, l, _ = h.shape
    q = (h @ w_q).reshape(b, l, MEM_HEADS, MEM_HEAD_DIM)
    s = jnp.einsum('blhd,bmhd->bhlm', q, mem_k).astype(jnp.float32) * MEM_HEAD_DIM ** -0.5
    p = jax.nn.softmax(s, axis=-1)
    o = jnp.einsum('bhlm,bmhd->blhd', p, mem_v).reshape(b, l, D_MODEL)
    return o @ w_o


def trunk_layer(x, pos, mem_k, mem_v, s5_re0, s5_im0, hg0, ret0, rw0, shift0, p, lb):
    h = rmsnorm(x, p['norm_mix'])
    proj = h @ p['w_in']
    o0 = S5_CH
    o1 = o0 + HG_COLS
    o2 = o1 + RET_COLS
    hg_q, hg_f, hg_i, hg_g = jnp.split(proj[..., o0:o1], 4, axis=-1)
    rt_q, rt_k, rt_v, rt_g = jnp.split(proj[..., o1:o2], 4, axis=-1)
    y_s5, s5_re, s5_im = s5_mixer(proj[..., :o0], p['s5_lam_re'], p['s5_lam_im'], p['s5_b_re'], p['s5_b_im'],
                                  p['s5_c_re'], p['s5_c_im'], p['s5_d'], p['s5_log_step'], p['s5_w_glu'],
                                  p['s5_b_glu'], p['s5_norm'], s5_re0, s5_im0)
    y_hg, hg_s = hgrn2_mixer(hg_q, hg_f, hg_i, hg_g, lb, p['hg_norm'], hg0)
    y_rt, rt_s = retention_mixer(rt_q, rt_k, rt_v, rt_g, pos, ret0)
    y_rw, rw_s, shift = rwkv7_mixer(proj[..., o2:], shift0, p['rw_mu'], p['rw_w0'], p['rw_w_w2'], p['rw_a0'],
                                    p['rw_w_a2'], p['rw_w_g2'], p['rw_k_k'], p['rw_k_a'], p['rw_r_k'],
                                    p['rw_ln_g'], p['rw_ln_b'], rw0)
    mix = jnp.concatenate([y_s5, y_hg, y_rt, y_rw], axis=-1)
    x = x + mix @ p['w_out']
    x = x + cross_attend(rmsnorm(x, p['norm_mem']), mem_k, mem_v, p['mem_w_q'], p['mem_w_o'])
    hf = rmsnorm(x, p['norm_ffn']) @ p['ffn_w_up']
    x = x + jnp.square(jax.nn.relu(hf)) @ p['ffn_w_down']
    return x, s5_re, s5_im, hg_s, rt_s, rw_s, shift


def setup_inputs(seed: int = 0) -> dict:
    key = jax.random.key(seed)
    ks = iter(jax.random.split(key, 64))
    f32 = jnp.float32

    def nrm(shape, scale):
        return scale * jax.random.normal(next(ks), shape, f32)

    def uni(shape, lo, hi):
        return jax.random.uniform(next(ks), shape, f32, lo, hi)

    def gain(shape):
        return 1.0 + nrm(shape, 0.01)

    H, D, G, P = N_MIX_HEADS, HEAD_DIM, S5_NGROUPS, S5_STATE
    gw = GROUP_WIDTH
    inp = {}
    inp['x_prompt'] = nrm((BATCH, SEQ, D_MODEL), 1.0)
    inp['x_sample'] = nrm((DEC_BATCH, DEC_SEQ, D_MODEL), 1.0)
    inp['mem_prompt'] = nrm((BATCH, MEM_LEN, D_MODEL), 1.0)
    inp['state_s5_re'] = nrm((DEPTH, DEC_BATCH, G, P), 0.5)
    inp['state_s5_im'] = nrm((DEPTH, DEC_BATCH, G, P), 0.5)
    inp['state_hgrn'] = nrm((DEPTH, DEC_BATCH, H, D, D), 0.3)
    inp['state_ret'] = nrm((DEPTH, DEC_BATCH, H, D, D), 1.0)
    inp['state_rwkv'] = nrm((DEPTH, DEC_BATCH, H, D, D), 0.3)
    inp['state_rwkv_shift'] = nrm((DEPTH, DEC_BATCH, RW_PROJ), 1.0)
    inp['cache_mem_k'] = nrm((DEPTH, DEC_BATCH, MEM_LEN, MEM_HEADS, MEM_HEAD_DIM), 1.0)
    inp['cache_mem_v'] = nrm((DEPTH, DEC_BATCH, MEM_LEN, MEM_HEADS, MEM_HEAD_DIM), 1.0)
    inp['norm_mix'] = gain((DEPTH, D_MODEL))
    inp['w_in'] = nrm((DEPTH, D_MODEL, IN_WIDTH), D_MODEL ** -0.5)
    inp['w_out'] = nrm((DEPTH, D_MODEL, D_MODEL), D_MODEL ** -0.5)
    inp['s5_lam_re'] = -0.5 * jnp.exp(nrm((DEPTH, G, P), 0.1))
    inp['s5_lam_im'] = jnp.pi * jnp.arange(P, dtype=f32)[None, None, :] + nrm((DEPTH, G, P), 0.01)
    inp['s5_b_re'] = nrm((DEPTH, G, P, S5_GROUP), (2 * S5_GROUP) ** -0.5)
    inp['s5_b_im'] = nrm((DEPTH, G, P, S5_GROUP), (2 * S5_GROUP) ** -0.5)
    inp['s5_c_re'] = nrm((DEPTH, G, S5_GROUP, P), (2 * P) ** -0.5)
    inp['s5_c_im'] = nrm((DEPTH, G, S5_GROUP, P), (2 * P) ** -0.5)
    inp['s5_d'] = nrm((DEPTH, G, S5_GROUP), 1.0)
    inp['s5_log_step'] = uni((DEPTH, G), math.log(S5_STEP_MIN), math.log(S5_STEP_MAX))
    inp['s5_w_glu'] = nrm((DEPTH, S5_CH, S5_CH), S5_CH ** -0.5)
    inp['s5_b_glu'] = nrm((DEPTH, S5_CH), 0.01)
    inp['s5_norm'] = gain((DEPTH, S5_CH))
    inp['hg_lb_logits'] = nrm((DEPTH, gw), 0.5)
    inp['hg_norm'] = gain((DEPTH, gw))
    inp['rw_mu'] = uni((DEPTH, RW_PROJ), 0.0, 1.0)
    inp['rw_w0'] = uni((DEPTH, gw), -6.0, 1.0)
    inp['rw_w_w2'] = nrm((DEPTH, RW_W_RANK, gw), 0.1)
    inp['rw_a0'] = nrm((DEPTH, gw), 0.5)
    inp['rw_w_a2'] = nrm((DEPTH, RW_A_RANK, gw), 0.1)
    inp['rw_w_g2'] = nrm((DEPTH, RW_G_RANK, gw), RW_G_RANK ** -0.5)
    inp['rw_k_k'] = 0.85 + nrm((DEPTH, gw), 0.05)
    inp['rw_k_a'] = 1.0 + nrm((DEPTH, gw), 0.05)
    inp['rw_r_k'] = nrm((DEPTH, gw), 0.1)
    inp['rw_ln_g'] = gain((DEPTH, gw))
    inp['rw_ln_b'] = nrm((DEPTH, gw), 0.01)
    inp['norm_mem'] = gain((DEPTH, D_MODEL))
    inp['mem_w_q'] = nrm((DEPTH, D_MODEL, D_MODEL), D_MODEL ** -0.5)
    inp['mem_w_k'] = nrm((DEPTH, D_MODEL, D_MODEL), D_MODEL ** -0.5)
    inp['mem_w_v'] = nrm((DEPTH, D_MODEL, D_MODEL), D_MODEL ** -0.5)
    inp['mem_w_o'] = nrm((DEPTH, D_MODEL, D_MODEL), D_MODEL ** -0.5)
    inp['norm_ffn'] = gain((DEPTH, D_MODEL))
    inp['ffn_w_up'] = nrm((DEPTH, D_MODEL, D_FF), D_MODEL ** -0.5)
    inp['ffn_w_down'] = nrm((DEPTH, D_FF, D_MODEL), D_FF ** -0.5)
    inp['norm_final'] = gain((D_MODEL,))
    return inp


def reference(x_prompt, x_sample, mem_prompt, state_s5_re, state_s5_im, state_hgrn, state_ret, state_rwkv,
              state_rwkv_shift, cache_mem_k, cache_mem_v, norm_mix, w_in, w_out, s5_lam_re, s5_lam_im,
              s5_b_re, s5_b_im, s5_c_re, s5_c_im, s5_d, s5_log_step, s5_w_glu, s5_b_glu, s5_norm,
              hg_lb_logits, hg_norm, rw_mu, rw_w0, rw_w_w2, rw_a0, rw_w_a2, rw_w_g2, rw_k_k, rw_k_a, rw_r_k,
              rw_ln_g, rw_ln_b, norm_mem, mem_w_q, mem_w_k, mem_w_v, mem_w_o, norm_ffn, ffn_w_up, ffn_w_down,
              norm_final):
    f32 = jnp.float32
    lb_all = jnp.cumsum(jax.nn.softmax(hg_lb_logits.astype(f32), axis=0), axis=0)
    lb_all = lb_all - lb_all[0:1]
    bp, lp = x_prompt.shape[0], x_prompt.shape[1]
    ls = x_sample.shape[1]
    pos_p = jnp.arange(lp, dtype=jnp.int32)
    pos_s = PAST_LEN + jnp.arange(ls, dtype=jnp.int32)
    z_s5 = jnp.zeros((bp, S5_NGROUPS, S5_STATE), f32)
    z_mat = jnp.zeros((bp, N_MIX_HEADS, HEAD_DIM, HEAD_DIM), f32)
    z_shift = jnp.zeros((bp, RW_PROJ), f32)
    yp, ys = x_prompt, x_sample
    p_re, p_im, p_hg, p_rt, p_rw, p_sh, p_mk, p_mv = [], [], [], [], [], [], [], []
    s_re, s_im, s_hg, s_rt, s_rw, s_sh = [], [], [], [], [], []
    for l in range(DEPTH):
        prm = {'norm_mix': norm_mix[l], 'w_in': w_in[l], 'w_out': w_out[l],
               's5_lam_re': s5_lam_re[l], 's5_lam_im': s5_lam_im[l], 's5_b_re': s5_b_re[l],
               's5_b_im': s5_b_im[l], 's5_c_re': s5_c_re[l], 's5_c_im': s5_c_im[l], 's5_d': s5_d[l],
               's5_log_step': s5_log_step[l], 's5_w_glu': s5_w_glu[l], 's5_b_glu': s5_b_glu[l],
               's5_norm': s5_norm[l], 'hg_norm': hg_norm[l], 'rw_mu': rw_mu[l], 'rw_w0': rw_w0[l],
               'rw_w_w2': rw_w_w2[l], 'rw_a0': rw_a0[l], 'rw_w_a2': rw_w_a2[l], 'rw_w_g2': rw_w_g2[l],
               'rw_k_k': rw_k_k[l], 'rw_k_a': rw_k_a[l], 'rw_r_k': rw_r_k[l], 'rw_ln_g': rw_ln_g[l],
               'rw_ln_b': rw_ln_b[l], 'norm_mem': norm_mem[l], 'mem_w_q': mem_w_q[l], 'mem_w_o': mem_w_o[l],
               'norm_ffn': norm_ffn[l], 'ffn_w_up': ffn_w_up[l], 'ffn_w_down': ffn_w_down[l]}
        mk, mv = memory_kv(mem_prompt, mem_w_k[l], mem_w_v[l])
        yp, a1, a2, a3, a4, a5, a6 = trunk_layer(yp, pos_p, mk, mv, z_s5, z_s5, z_mat, z_mat, z_mat, z_shift,
                                                 prm, lb_all[l])
        p_re.append(a1); p_im.append(a2); p_hg.append(a3); p_rt.append(a4); p_rw.append(a5); p_sh.append(a6)
        p_mk.append(mk); p_mv.append(mv)
        ys, b1, b2, b3, b4, b5, b6 = trunk_layer(ys, pos_s, cache_mem_k[l], cache_mem_v[l], state_s5_re[l],
                                                 state_s5_im[l], state_hgrn[l], state_ret[l], state_rwkv[l],
                                                 state_rwkv_shift[l], prm, lb_all[l])
        s_re.append(b1); s_im.append(b2); s_hg.append(b3); s_rt.append(b4); s_rw.append(b5); s_sh.append(b6)
    y_prompt = rmsnorm(yp, norm_final)
    y_sample = rmsnorm(ys, norm_final)
    return (y_prompt, y_sample,
            jnp.stack(p_re), jnp.stack(p_im), jnp.stack(p_hg), jnp.stack(p_rt), jnp.stack(p_rw), jnp.stack(p_sh),
            jnp.stack(p_mk), jnp.stack(p_mv),
            jnp.stack(s_re), jnp.stack(s_im), jnp.stack(s_hg), jnp.stack(s_rt), jnp.stack(s_rw), jnp.stack(s_sh))
```

```cpp
#include <hip/hip_runtime.h>
#include <hip/hip_cooperative_groups.h>
#include <cstdio>
namespace cg = cooperative_groups;

#define LAS __attribute__((address_space(3)))
typedef unsigned short bf16_t;
typedef float f32x2 __attribute__((ext_vector_type(2)));
typedef unsigned u32x2 __attribute__((ext_vector_type(2)));

constexpr int T_ALL = 17408, T_P = 16384, T_S = 1024, DM = 1024, INW = 3328, DFF = 4096;
constexpr int NTHR = 512;
constexpr int LDS_BYTES = 147456;

constexpr size_t al(size_t x) { return (x + 255) & ~(size_t)255; }
constexpr size_t SZ_WIN = (size_t)INW * DM * 2, SZ_SQ = (size_t)DM * DM * 2, SZ_UP = (size_t)DFF * DM * 2, SZ_GLU = 256 * 256 * 2;
constexpr size_t WL_IN = 0, WL_OUT = WL_IN + SZ_WIN, WL_Q = WL_OUT + SZ_SQ, WL_K = WL_Q + SZ_SQ, WL_V = WL_K + SZ_SQ, WL_O = WL_V + SZ_SQ,
                 WL_UP = WL_O + SZ_SQ, WL_DOWN = WL_UP + SZ_UP, WL_GLU = WL_DOWN + SZ_UP, WL_SIZE = WL_GLU + SZ_GLU;
constexpr size_t WS_WT = 0;
constexpr size_t WS_MEMB = al(WS_WT + 2 * WL_SIZE);
constexpr size_t WS_XRES = al(WS_MEMB + (size_t)2048 * DM * 2);
constexpr size_t WS_HA = al(WS_XRES + (size_t)T_ALL * DM * 4);
constexpr size_t WS_MIX = al(WS_HA + (size_t)T_ALL * DM * 2);
constexpr size_t WS_QB = al(WS_MIX + (size_t)T_ALL * DM * 2);
constexpr size_t WS_OB = al(WS_QB + (size_t)T_ALL * DM * 2);
constexpr size_t WS_HID = al(WS_OB + (size_t)T_ALL * DM * 2);
constexpr size_t WS_PROJ = al(WS_HID + (size_t)T_ALL * DFF * 2);
constexpr size_t WS_REC = al(WS_PROJ + (size_t)T_ALL * INW * 4);
constexpr size_t WS_GATE = al(WS_REC + (size_t)T_ALL * 1536 * 4);
constexpr size_t WS_ORAW = al(WS_GATE + (size_t)T_ALL * 256 * 4);
constexpr size_t WS_YSF = al(WS_ORAW + (size_t)T_ALL * 768 * 4);
constexpr size_t WS_YSB = al(WS_YSF + (size_t)T_ALL * 256 * 4);
constexpr size_t WS_GLUO = al(WS_YSB + (size_t)T_ALL * 256 * 2);
constexpr size_t WS_S5E = al(WS_GLUO + (size_t)T_ALL * 256 * 4);
constexpr size_t WS_S5C = al(WS_S5E + (size_t)8 * 16 * 32 * 128 * 4);
constexpr size_t WS_ROPE = al(WS_S5C + (size_t)2 * 36864 * 4);
constexpr size_t WS_LB = al(WS_ROPE + (size_t)2056 * 64 * 4);
constexpr size_t WS_KB = al(WS_LB + 2 * 256 * 4);
constexpr size_t WS_VT = al(WS_KB + (size_t)2 * 32 * 65536 * 2);
constexpr size_t WS_END = al(WS_VT + (size_t)2 * 32 * 65536 * 2);

constexpr size_t O_Y = 0;
constexpr size_t O_PRE = (size_t)T_ALL * DM;
constexpr size_t O_PIM = O_PRE + 16384;
constexpr size_t O_PHG = O_PIM + 16384;
constexpr size_t O_PRT = O_PHG + 262144;
constexpr size_t O_PRW = O_PRT + 262144;
constexpr size_t O_PSH = O_PRW + 262144;
constexpr size_t O_PMK = O_PSH + 16384;
constexpr size_t O_PMV = O_PMK + 4194304;
constexpr size_t O_SRE = O_PMV + 4194304;
constexpr size_t O_SIM = O_SRE + 262144;
constexpr size_t O_SHG = O_SIM + 262144;
constexpr size_t O_SRT = O_SHG + 4194304;
constexpr size_t O_SRW = O_SRT + 4194304;
constexpr size_t O_SSH = O_SRW + 4194304;
constexpr size_t O_END = O_SSH + 262144;

struct Params {
  const float* in[47];
  float* out;
  unsigned char* ws;
  int ph_lo, ph_hi;
};

enum { I_XP = 0, I_XS, I_MEM, I_S5RE, I_S5IM, I_SHG, I_SRT, I_SRW, I_SSHIFT, I_CK, I_CV, I_NMIX, I_WIN, I_WOUT, I_LAMRE, I_LAMIM,
       I_BRE, I_BIM, I_CRE, I_CIM, I_S5D, I_LOGSTEP, I_WGLU, I_BGLU, I_S5NORM, I_LBLOG, I_HGNORM, I_RWMU, I_RWW0, I_RWW2, I_RWA0,
       I_RWA2, I_RWG2, I_RWKK, I_RWKA, I_RWRK, I_RWLNG, I_RWLNB, I_NMEM, I_WQ, I_WK, I_WV, I_WO, I_NFFN, I_WUP, I_WDOWN, I_NFINAL };

__device__ __forceinline__ unsigned short f2bf(float f) { unsigned u = __float_as_uint(f); u += 0x7FFFu + ((u >> 16) & 1u); return (unsigned short)(u >> 16); }
__device__ __forceinline__ unsigned pack2(float lo, float hi) { return (unsigned)f2bf(lo) | ((unsigned)f2bf(hi) << 16); }
__device__ __forceinline__ float bf2f(unsigned short b) { return __uint_as_float(((unsigned)b) << 16); }
__device__ __forceinline__ float sigm(float x) { return 1.0f / (1.0f + __expf(-x)); }
__device__ __forceinline__ float siluf(float x) { return x * sigm(x); }
__device__ __forceinline__ float row_sum16(float x) {
  x += __int_as_float(__builtin_amdgcn_update_dpp(0, __float_as_int(x), 0x128, 0xf, 0xf, false));
  x += __int_as_float(__builtin_amdgcn_update_dpp(0, __float_as_int(x), 0x124, 0xf, 0xf, false));
  x += __int_as_float(__builtin_amdgcn_update_dpp(0, __float_as_int(x), 0x122, 0xf, 0xf, false));
  x += __int_as_float(__builtin_amdgcn_update_dpp(0, __float_as_int(x), 0x121, 0xf, 0xf, false));
  return x;
}
__device__ __forceinline__ float shx(float x, int off, int lane) { return __int_as_float(__builtin_amdgcn_ds_bpermute((lane ^ off) << 2, __float_as_int(x))); }
__device__ __forceinline__ float wave_sum(float x, int lane) { x = row_sum16(x); x += shx(x, 16, lane); x += shx(x, 32, lane); return x; }
__device__ __forceinline__ float wave_max(float x, int lane) {
#pragma unroll
  for (int o = 32; o >= 1; o >>= 1) x = fmaxf(x, shx(x, o, lane));
  return x;
}
__device__ __forceinline__ void dsincos(double x, double& s, double& c) {
  const double n = rint(x * 0.15915494309189535);
  double r = (x - n * 6.283185307179586) * 0.125;
  const double r2 = r * r;
  double sn = r * (1.0 - r2 / 6.0 * (1.0 - r2 / 20.0 * (1.0 - r2 / 42.0 * (1.0 - r2 / 72.0 * (1.0 - r2 / 110.0 * (1.0 - r2 / 156.0))))));
  double cs = 1.0 - r2 / 2.0 * (1.0 - r2 / 12.0 * (1.0 - r2 / 30.0 * (1.0 - r2 / 56.0 * (1.0 - r2 / 90.0 * (1.0 - r2 / 132.0)))));
#pragma unroll
  for (int i = 0; i < 3; ++i) { const double s2 = 2.0 * sn * cs, c2 = 1.0 - 2.0 * sn * sn; sn = s2; cs = c2; }
  s = sn; c = cs;
}

typedef const __attribute__((address_space(4))) Params* KP;
__device__ __forceinline__ KP get_params() { KP k = (KP)__builtin_amdgcn_kernarg_segment_ptr(); asm volatile("" : "+s"(k)); return k; }
namespace pg8 {
#define PG8_LAS __attribute__((address_space(3)))
typedef unsigned short bf16_t;
typedef short bf16x8 __attribute__((ext_vector_type(8)));
typedef float f32x4 __attribute__((ext_vector_type(4)));
typedef unsigned u32x4 __attribute__((ext_vector_type(4)));
constexpr int BM = 256, BK = 64, HALF = 128, HTB = HALF * BK * 2  , STAGE_BYTES = 8 * HTB, NXCD = 8, WGM = 8;

__host__ __device__ __forceinline__ int lds_byte(int r, int c) { const int st = (r >> 4) * 2 + (c >> 5), rr = r & 15, cc = c & 31, ob = rr * 64 + cc * 2; return st * 1024 + (ob ^ (((ob >> 9) & 1) << 5)); }
__host__ __device__ __forceinline__ void stage_rc(int b, int& R, int& C) { const int st = b / 1024, sb = b % 1024, swz = sb ^ (((sb >> 9) & 1) << 5); R = (st >> 1) * 16 + swz / 64; C = (st & 1) * 32 + (swz % 64) / 2; }
__host__ __device__ __forceinline__ int perm32(int rho) { const int n = rho >> 4, i = rho & 15; return 8 * (i >> 2) + 4 * n + (i & 3); }

struct Unit { int pm, pn; };
struct Gemm { const bf16_t* A; const bf16_t* Bt; int M, N, K; };

struct StaticOrder {
    int nM, nN, nwg, G, c;
    __host__ __device__ void init(int M, int N, int G_, int c_) { nM = M / BM; nN = N / BM; nwg = nM * nN; G = G_; c = c_; }
    __host__ __device__ bool next(int i, Unit& u) const {
        const long L = (long)i * G + c; if (L >= nwg) return false;
        int wgid = (int)L; { const int q = nwg / NXCD, r = nwg % NXCD, xcd = wgid % NXCD, off = wgid / NXCD; wgid = (xcd < r ? xcd * (q + 1) : r * (q + 1) + (xcd - r) * q) + off; }
        const int nig = WGM * nN, gid = wgid / nig, fm = gid * WGM, gsz = (nM - fm) < WGM ? (nM - fm) : WGM;
        u.pm = fm + ((wgid % nig) % gsz); u.pn = (wgid % nig) / gsz; return true;
    }
    __device__ __forceinline__ void a_ready(const Unit&) const {}
    __device__ __forceinline__ void done(const Unit&) const {}
};
__device__ __forceinline__ unsigned cvt_pk_bf16(float lo, float hi) { unsigned r; asm volatile("v_cvt_pk_bf16_f32 %0, %1, %2" : "=v"(r) : "v"(lo), "v"(hi)); return r; }
typedef float f32x2 __attribute__((ext_vector_type(2)));
__device__ __forceinline__ f32x2 gelu_pk(f32x2 v) {
    const f32x2 av = __builtin_elementwise_abs(v), d = av * 0.2316418882f + 1.0f;
    f32x2 t; t.x = __builtin_amdgcn_rcpf(d.x); t.y = __builtin_amdgcn_rcpf(d.y);
    f32x2 q = t * 0.5307027145f + (-0.7265760135f); q = q * t + 0.7107068705f; q = q * t + (-0.142248368f); q = q * t + 0.127414796f; q = q * t;
    const f32x2 s = (v * v) * (-0.72134752044f);
    f32x2 e; e.x = __builtin_amdgcn_exp2f(s.x); e.y = __builtin_amdgcn_exp2f(s.y);
    const f32x2 m = v * (q * e), r = v - m;
    f32x2 o; o.x = v.x < 0.f ? m.x : r.x; o.y = v.y < 0.f ? m.y : r.y; return o;
}
template <class Epi, class Sched>
__device__ __forceinline__ void gemm_phase(PG8_LAS unsigned char* lds, const Gemm g, const Sched& S, const Epi& E, const int tid_in) {
    const int tid = tid_in, wid = __builtin_amdgcn_readfirstlane(tid >> 6), lane = tid & 63, wr = wid >> 2, wc = wid & 3, fr = lane & 15, fq = lane >> 4;
    const int K = g.K, nt = K / BK;
    unsigned voffA[2], voffB[2];
#pragma unroll
    for (int i = 0; i < 2; ++i) { int R, C; stage_rc(tid * 16 + i * 8192, R, C); const int Rb = Epi::PERM ? ((R & ~31) + perm32(R & 31)) : R;
        voffA[i] = (unsigned)(R * K + C) * 2u; voffB[i] = (unsigned)(Rb * K + C) * 2u; }
    const size_t kstep = (size_t)(BK * 2);
    const size_t hstep = (size_t)HALF * K * 2;
    const size_t tstep = 2 * hstep;
    const unsigned ldsw = (unsigned)wid * 1024u;
    const int aoff = lds_byte(wr * 64 + fr, fq * 8), boff = lds_byte(wc * 32 + fr, fq * 8);
#define PG8_SA(b, h) (((b) * 2 + (h)) * HTB)
#define PG8_SB(b, h) ((4 + (b) * 2 + (h)) * HTB)
#define PG8_STAGE(bufoff, gbase, voff) do { _Pragma("unroll") for (int _i = 0; _i < 2; ++_i) \
        __builtin_amdgcn_global_load_lds((const unsigned*)((const char*)(gbase) + (voff)[_i]), (PG8_LAS unsigned*)(lds + (bufoff) + ldsw + _i * 8192), 16, 0, 0); } while (0)
#define PG8_LDA(dst, b, h) do { _Pragma("unroll") for (int m = 0; m < 4; ++m) _Pragma("unroll") for (int k = 0; k < 2; ++k) dst[m][k] = *(const PG8_LAS bf16x8*)(lds + PG8_SA(b, h) + aoff + m * 2048 + k * 1024); } while (0)
#define PG8_LDB(dst, b, h) do { _Pragma("unroll") for (int n = 0; n < 2; ++n) _Pragma("unroll") for (int k = 0; k < 2; ++k) dst[n][k] = *(const PG8_LAS bf16x8*)(lds + PG8_SB(b, h) + boff + n * 2048 + k * 1024); } while (0)
#define PG8_MMA(ai, bj, At, Bt) do { __builtin_amdgcn_s_setprio(1); _Pragma("unroll") for (int m = 0; m < 4; ++m) _Pragma("unroll") for (int n = 0; n < 2; ++n) _Pragma("unroll") for (int k = 0; k < 2; ++k) \
        acc[ai][bj][m][n] = __builtin_amdgcn_mfma_f32_16x16x32_bf16(Bt[n][k], At[m][k], acc[ai][bj][m][n], 0, 0, 0); __builtin_amdgcn_s_setprio(0); } while (0)
#define PG8_WAIT_V(n) asm volatile("s_waitcnt vmcnt(" #n ")" ::: "memory")
#define PG8_WAIT_L(n) asm volatile("s_waitcnt lgkmcnt(" #n ")" ::: "memory")
#define PG8_BAR __builtin_amdgcn_s_barrier()
#define PG8_SCHED __builtin_amdgcn_sched_barrier(0)
    Unit cur, nxt; int ui = 0;
    if (!S.next(0, cur)) return;
    f32x4 acc[2][2][4][2];
#pragma unroll
    for (int a = 0; a < 2; ++a)
#pragma unroll
        for (int b = 0; b < 2; ++b)
#pragma unroll
            for (int m = 0; m < 4; ++m)
#pragma unroll
                for (int n = 0; n < 2; ++n) acc[a][b][m][n] = (f32x4){0.f, 0.f, 0.f, 0.f};
    bf16x8 At[4][2], B0[2][2], B1[2][2];
    const char* cA = (const char*)g.A + (size_t)cur.pm * tstep; const char* cB = (const char*)g.Bt + (size_t)cur.pn * tstep;
    S.a_ready(cur);
    PG8_STAGE(PG8_SB(0, 0), cB, voffB); PG8_STAGE(PG8_SA(0, 0), cA, voffA); PG8_STAGE(PG8_SB(0, 1), cB + hstep, voffB); PG8_STAGE(PG8_SA(0, 1), cA + hstep, voffA);
    if (wr == 1) PG8_BAR;
    PG8_WAIT_V(4); PG8_BAR;
    PG8_STAGE(PG8_SB(1, 0), cB + kstep, voffB); PG8_STAGE(PG8_SA(1, 0), cA + kstep, voffA); PG8_STAGE(PG8_SB(1, 1), cB + hstep + kstep, voffB);
    PG8_WAIT_V(6); PG8_BAR;
    for (;;) {
        const bool has_next = S.next(ui + 1, nxt);
        const char* nA = has_next ? (const char*)g.A + (size_t)nxt.pm * tstep : cA; const char* nB = has_next ? (const char*)g.Bt + (size_t)nxt.pn * tstep : cB;
        for (int t = 0; t < nt; t += 2) {
            const bool last = (t == nt - 2);
            const char* a1 = cA + (size_t)(t + 1) * kstep;
            const char* a2 = last ? nA : cA + (size_t)(t + 2) * kstep; const char* b2 = last ? nB : cB + (size_t)(t + 2) * kstep;
            const char* a3 = a2 + kstep; const char* b3 = b2 + kstep;
            if (last && has_next) S.a_ready(nxt);
            PG8_LDB(B0, 0, 0); PG8_SCHED; PG8_LDA(At, 0, 0); PG8_STAGE(PG8_SA(1, 1), a1 + hstep, voffA);
            PG8_WAIT_L(8); PG8_BAR; PG8_WAIT_L(0); PG8_MMA(0, 0, At, B0); PG8_BAR; PG8_SCHED;
            PG8_LDB(B1, 0, 1); PG8_STAGE(PG8_SB(0, 0), b2, voffB);
            PG8_BAR; PG8_WAIT_L(0); PG8_MMA(0, 1, At, B1); PG8_BAR;
            PG8_LDA(At, 0, 1); PG8_STAGE(PG8_SA(0, 0), a2, voffA);
            PG8_BAR; PG8_WAIT_L(0); PG8_MMA(1, 0, At, B0); PG8_BAR; PG8_SCHED;
            PG8_STAGE(PG8_SB(0, 1), b2 + hstep, voffB);
            PG8_WAIT_V(6); PG8_BAR; PG8_MMA(1, 1, At, B1); PG8_BAR;
            PG8_LDB(B0, 1, 0); PG8_SCHED; PG8_LDA(At, 1, 0); PG8_STAGE(PG8_SA(0, 1), a2 + hstep, voffA);
            PG8_WAIT_L(8); PG8_BAR; PG8_WAIT_L(0); PG8_MMA(0, 0, At, B0); PG8_BAR; PG8_SCHED;
            PG8_LDB(B1, 1, 1); PG8_STAGE(PG8_SB(1, 0), b3, voffB);
            PG8_BAR; PG8_WAIT_L(0); PG8_MMA(0, 1, At, B1); PG8_BAR;
            PG8_LDA(At, 1, 1); PG8_STAGE(PG8_SA(1, 0), a3, voffA);
            PG8_BAR; PG8_WAIT_L(0); PG8_MMA(1, 0, At, B0); PG8_BAR; PG8_SCHED;
            PG8_STAGE(PG8_SB(1, 1), b3 + hstep, voffB);
            PG8_WAIT_V(6); PG8_BAR; PG8_MMA(1, 1, At, B1); PG8_BAR;
        }
        if constexpr (!Epi::AFTER_DRAIN) { E(acc, cur, wr, wc, fr, fq); S.done(cur); }
        if (!has_next) break;
#pragma unroll
        for (int a = 0; a < 2; ++a)
#pragma unroll
            for (int b = 0; b < 2; ++b)
#pragma unroll
                for (int m = 0; m < 4; ++m)
#pragma unroll
                    for (int n = 0; n < 2; ++n) acc[a][b][m][n] = (f32x4){0.f, 0.f, 0.f, 0.f};
        cur = nxt; cA = nA; cB = nB; ++ui;
    }
    PG8_WAIT_V(0);
    if (wr == 0) PG8_BAR;
    PG8_BAR;
    if constexpr (Epi::AFTER_DRAIN) { E.fused(acc, cur, wr, wc, fr, fq, lds, wid, lane); S.done(cur); }
#undef PG8_SA
#undef PG8_SB
#undef PG8_STAGE
#undef PG8_LDA
#undef PG8_LDB
#undef PG8_MMA
#undef PG8_WAIT_V
#undef PG8_WAIT_L
#undef PG8_BAR
#undef PG8_SCHED
}
}

struct Ctx { int tid, bid, G; };
using pg8::bf16x8; using pg8::f32x4; using pg8::u32x4; using pg8::Unit; using pg8::cvt_pk_bf16;
constexpr int HALF = 128;

struct EpiStoreF32 {
  static constexpr bool PERM = false, AFTER_DRAIN = false;
  float* C; int ldc;
  __device__ __forceinline__ void operator()(const f32x4 (&acc)[2][2][4][2], const Unit& u, int wr, int wc, int fr, int fq) const {
    const int row0 = u.pm * 256 + wr * 64 + fr, col0 = u.pn * 256 + wc * 32 + 4 * fq;
#pragma unroll
    for (int ai = 0; ai < 2; ++ai)
#pragma unroll
      for (int m = 0; m < 4; ++m) { float* rowp = C + (size_t)(row0 + ai * HALF + m * 16) * ldc + col0;
#pragma unroll
        for (int bj = 0; bj < 2; ++bj)
#pragma unroll
          for (int n = 0; n < 2; ++n) *(f32x4*)(rowp + bj * HALF + n * 16) = acc[ai][bj][m][n]; }
  }
};
struct EpiRes {
  static constexpr bool PERM = false, AFTER_DRAIN = false;
  float* X;
  __device__ __forceinline__ void operator()(const f32x4 (&acc)[2][2][4][2], const Unit& u, int wr, int wc, int fr, int fq) const {
    const int row0 = u.pm * 256 + wr * 64 + fr, col0 = u.pn * 256 + wc * 32 + 4 * fq;
#pragma unroll
    for (int ai = 0; ai < 2; ++ai)
#pragma unroll
      for (int m = 0; m < 4; ++m) { float* rowp = X + (size_t)(row0 + ai * HALF + m * 16) * DM + col0;
        f32x4 o[2][2];
#pragma unroll
        for (int bj = 0; bj < 2; ++bj)
#pragma unroll
          for (int n = 0; n < 2; ++n) o[bj][n] = *(const f32x4*)(rowp + bj * HALF + n * 16);
#pragma unroll
        for (int bj = 0; bj < 2; ++bj)
#pragma unroll
          for (int n = 0; n < 2; ++n) *(f32x4*)(rowp + bj * HALF + n * 16) = o[bj][n] + acc[ai][bj][m][n];
        asm volatile("" ::: "memory"); }
  }
};
template <int ACT> struct EpiBf {
  static constexpr bool PERM = true, AFTER_DRAIN = false;
  bf16_t* O; int ldc;
  __device__ __forceinline__ void operator()(const f32x4 (&acc)[2][2][4][2], const Unit& u, int wr, int wc, int fr, int fq) const {
    const int row0 = u.pm * 256 + wr * 64 + fr, col0 = u.pn * 256 + wc * 32 + 8 * fq;
#pragma unroll
    for (int ai = 0; ai < 2; ++ai)
#pragma unroll
      for (int m = 0; m < 4; ++m) { bf16_t* rowp = O + (size_t)(row0 + ai * HALF + m * 16) * ldc + col0;
#pragma unroll
        for (int bj = 0; bj < 2; ++bj) { f32x4 v0 = acc[ai][bj][m][0], v1 = acc[ai][bj][m][1];
          if (ACT == 1) {
#pragma unroll
            for (int j = 0; j < 4; ++j) { const float a = fmaxf(v0[j], 0.f), b = fmaxf(v1[j], 0.f); v0[j] = a * a; v1[j] = b * b; } }
          u32x4 w; w.x = cvt_pk_bf16(v0[0], v0[1]); w.y = cvt_pk_bf16(v0[2], v0[3]); w.z = cvt_pk_bf16(v1[0], v1[1]); w.w = cvt_pk_bf16(v1[2], v1[3]);
          *(u32x4*)(rowp + bj * HALF) = w; } }
  }
};
struct EpiMemK {
  static constexpr bool PERM = false, AFTER_DRAIN = false;
  float* C; bf16_t* Kb;
  __device__ __forceinline__ void operator()(const f32x4 (&acc)[2][2][4][2], const Unit& u, int wr, int wc, int fr, int fq) const {
    const int rl0 = wr * 64 + fr, cl0 = wc * 32 + 4 * fq;
    bf16_t* kb = Kb + (size_t)(u.pm * 4 + u.pn) * 65536;
#pragma unroll
    for (int ai = 0; ai < 2; ++ai)
#pragma unroll
      for (int m = 0; m < 4; ++m) { const int rl = rl0 + ai * HALF + m * 16; float* rowp = C + (size_t)(u.pm * 256 + rl) * DM + u.pn * 256 + cl0;
#pragma unroll
        for (int bj = 0; bj < 2; ++bj)
#pragma unroll
          for (int n = 0; n < 2; ++n) { const f32x4 v = acc[ai][bj][m][n]; *(f32x4*)(rowp + bj * HALF + n * 16) = v;
            u32x2 w; w.x = cvt_pk_bf16(v[0], v[1]); w.y = cvt_pk_bf16(v[2], v[3]); *(u32x2*)(kb + rl * 256 + cl0 + bj * HALF + n * 16) = w; } }
  }
};
struct EpiVt {
  static constexpr bool PERM = true, AFTER_DRAIN = false;
  bf16_t* Vt;
  __device__ __forceinline__ void operator()(const f32x4 (&acc)[2][2][4][2], const Unit& u, int wr, int wc, int fr, int fq) const {
    bf16_t* vt = Vt + (size_t)(u.pn * 4 + u.pm) * 65536; const int rl0 = wr * 64 + fr, cl0 = wc * 32 + 8 * fq;
#pragma unroll
    for (int ai = 0; ai < 2; ++ai)
#pragma unroll
      for (int m = 0; m < 4; ++m) { bf16_t* rowp = vt + (rl0 + ai * HALF + m * 16) * 256 + cl0;
#pragma unroll
        for (int bj = 0; bj < 2; ++bj) { const f32x4 v0 = acc[ai][bj][m][0], v1 = acc[ai][bj][m][1];
          u32x4 w; w.x = cvt_pk_bf16(v0[0], v0[1]); w.y = cvt_pk_bf16(v0[2], v0[3]); w.z = cvt_pk_bf16(v1[0], v1[1]); w.w = cvt_pk_bf16(v1[2], v1[3]);
          *(u32x4*)(rowp + bj * HALF) = w; } }
  }
};
template <class Epi>
__device__ __forceinline__ void run_gemm(const Ctx cx0, LAS unsigned char* lds, const bf16_t* A, const bf16_t* Bt, int M, int N, int K, const Epi& E, int cid) {
  Ctx cx = cx0; asm volatile("" : "+v"(cx.tid));
  pg8::Gemm g{A, Bt, M, N, K}; pg8::StaticOrder S; S.init(M, N, cx.G, cid);
  pg8::gemm_phase<Epi, pg8::StaticOrder>(lds, g, S, E, cx.tid);
}

__device__ void transpose_tile(const Ctx cx, const float* W, int K, int N, bf16_t* Wt, int tk, int tn, float* tl) {
  const int tid = cx.tid;
#pragma unroll
  for (int h = 0; h < 2; ++h) { const int k = (tid >> 4) + h * 32, nc = (tid & 15) * 4;
    const float4 v = *(const float4*)(W + (size_t)(tk * 64 + k) * N + tn * 64 + nc);
    tl[k * 65 + nc] = v.x; tl[k * 65 + nc + 1] = v.y; tl[k * 65 + nc + 2] = v.z; tl[k * 65 + nc + 3] = v.w; }
  __syncthreads();
  { const int n = tid >> 3, kc = (tid & 7) * 8; u32x4 w;
    w.x = pack2(tl[(kc + 0) * 65 + n], tl[(kc + 1) * 65 + n]); w.y = pack2(tl[(kc + 2) * 65 + n], tl[(kc + 3) * 65 + n]);
    w.z = pack2(tl[(kc + 4) * 65 + n], tl[(kc + 5) * 65 + n]); w.w = pack2(tl[(kc + 6) * 65 + n], tl[(kc + 7) * 65 + n]);
    *(u32x4*)(Wt + (size_t)(tn * 64 + n) * K + tk * 64 + kc) = w; }
  __syncthreads();
}

template <bool FINAL, bool COPY>
__device__ void rms_rows(const Ctx cx, const float* srcA, const float* srcB, const float* gain, bf16_t* outb, float* outf, float* xres) {
  const int lane = cx.tid & 63, gw = cx.bid * 8 + (cx.tid >> 6), nw = cx.G * 8;
  float4 g[4];
#pragma unroll
  for (int q = 0; q < 4; ++q) g[q] = *(const float4*)(gain + q * 256 + lane * 4);
  for (int t = gw; t < T_ALL; t += nw) {
    const float* src = (t < T_P) ? srcA + (size_t)t * DM : srcB + (size_t)(t - T_P) * DM;
    float4 v[4]; float ss = 0.f;
#pragma unroll
    for (int q = 0; q < 4; ++q) { v[q] = *(const float4*)(src + q * 256 + lane * 4); ss += v[q].x * v[q].x + v[q].y * v[q].y + v[q].z * v[q].z + v[q].w * v[q].w; }
    ss = wave_sum(ss, lane);
    const float r = rsqrtf(ss * (1.0f / 1024.0f) + 1e-6f);
#pragma unroll
    for (int q = 0; q < 4; ++q) {
      if (COPY) *(float4*)(xres + (size_t)t * DM + q * 256 + lane * 4) = v[q];
      const float a = v[q].x * r * g[q].x, b = v[q].y * r * g[q].y, c = v[q].z * r * g[q].z, d = v[q].w * r * g[q].w;
      if (FINAL) { float4 o; o.x = a; o.y = b; o.z = c; o.w = d; *(float4*)(outf + (size_t)t * DM + q * 256 + lane * 4) = o; }
      else { u32x2 w; w.x = pack2(a, b); w.y = pack2(c, d); *(u32x2*)(outb + (size_t)t * DM + q * 256 + lane * 4) = w; }
    }
  }
}

__device__ void phase_prep(KP p, const Ctx cx, unsigned char* ldsraw) {
  const int tid = cx.tid;
  float* tl = (float*)ldsraw;
  for (int u = cx.bid; u < 2 * 4176; u += cx.G) {
    const int l = u / 4176, r = u % 4176;
    bf16_t* wl = (bf16_t*)(p->ws + WS_WT + (size_t)l * WL_SIZE);
    const float* W; int K, N; bf16_t* Wt; int tt;
    if (r < 832) { W = p->in[I_WIN] + (size_t)l * DM * INW; K = DM; N = INW; Wt = (bf16_t*)((unsigned char*)wl + WL_IN); tt = r; }
    else if (r < 1088) { W = p->in[I_WOUT] + (size_t)l * DM * DM; K = DM; N = DM; Wt = (bf16_t*)((unsigned char*)wl + WL_OUT); tt = r - 832; }
    else if (r < 1344) { W = p->in[I_WQ] + (size_t)l * DM * DM; K = DM; N = DM; Wt = (bf16_t*)((unsigned char*)wl + WL_Q); tt = r - 1088; }
    else if (r < 1600) { W = p->in[I_WK] + (size_t)l * DM * DM; K = DM; N = DM; Wt = (bf16_t*)((unsigned char*)wl + WL_K); tt = r - 1344; }
    else if (r < 1856) { W = p->in[I_WV] + (size_t)l * DM * DM; K = DM; N = DM; Wt = (bf16_t*)((unsigned char*)wl + WL_V); tt = r - 1600; }
    else if (r < 2112) { W = p->in[I_WO] + (size_t)l * DM * DM; K = DM; N = DM; Wt = (bf16_t*)((unsigned char*)wl + WL_O); tt = r - 1856; }
    else if (r < 3136) { W = p->in[I_WUP] + (size_t)l * DM * DFF; K = DM; N = DFF; Wt = (bf16_t*)((unsigned char*)wl + WL_UP); tt = r - 2112; }
    else if (r < 4160) { W = p->in[I_WDOWN] + (size_t)l * DFF * DM; K = DFF; N = DM; Wt = (bf16_t*)((unsigned char*)wl + WL_DOWN); tt = r - 3136; }
    else { W = p->in[I_WGLU] + (size_t)l * 65536; K = 256; N = 256; Wt = (bf16_t*)((unsigned char*)wl + WL_GLU); tt = r - 4160; }
    const int ntn = N / 64;
    transpose_tile(cx, W, K, N, Wt, tt / ntn, tt % ntn, tl);
  }
  const int gid = cx.bid * NTHR + tid, gsz = cx.G * NTHR;
  { const float* mem = p->in[I_MEM]; bf16_t* mb = (bf16_t*)(p->ws + WS_MEMB);
    for (int i = gid; i < 2048 * DM / 4; i += gsz) { const float4 v = *(const float4*)(mem + (size_t)i * 4); u32x2 w; w.x = pack2(v.x, v.y); w.y = pack2(v.z, v.w); *(u32x2*)(mb + (size_t)i * 4) = w; } }
  for (int i = gid; i < 2048; i += gsz) {
    const int l = (int)(i >> 10), gp = (int)(i & 1023), g = gp >> 6;
    float* cst = (float*)(p->ws + WS_S5C) + (size_t)l * 36864;
    const double lre = (double)p->in[I_LAMRE][l * 1024 + gp], lim = (double)p->in[I_LAMIM][l * 1024 + gp];
    const double step = exp((double)p->in[I_LOGSTEP][l * 16 + g]);
    double sn, cs; dsincos(lim * step, sn, cs);
    const double mag = exp(lre * step), bre_ = mag * cs, bim_ = mag * sn;
    cst[gp] = (float)bre_; cst[1024 + gp] = (float)bim_;
    double pr = bre_, pi = bim_;
#pragma unroll 1
    for (int q = 0; q < 6; ++q) { const double nr = pr * pr - pi * pi, ni = 2.0 * pr * pi; pr = nr; pi = ni; }
    cst[2048 + gp] = (float)pr; cst[3072 + gp] = (float)pi;
    const double nr_ = bre_ - 1.0, ni_ = bim_, den = lre * lre + lim * lim;
    const double fr_ = (nr_ * lre + ni_ * lim) / den, fi_ = (ni_ * lre - nr_ * lim) / den;
    for (int h = 0; h < 16; ++h) { const double br = (double)p->in[I_BRE][((size_t)l * 1024 + gp) * 16 + h], bi = (double)p->in[I_BIM][((size_t)l * 1024 + gp) * 16 + h];
      cst[4096 + gp * 16 + h] = (float)(fr_ * br - fi_ * bi); cst[4096 + 16384 + gp * 16 + h] = (float)(fr_ * bi + fi_ * br); }
  }
  for (int i = gid; i < 2056 * 32; i += gsz) {
    const int pi_ = (int)(i >> 5), j = (int)(i & 31);
    const float inv = (float)exp(-(double)j * (1.0 / 32.0) * 9.210340371976184);
    const float pos = (float)(pi_ < 2048 ? pi_ : 16384 + (pi_ - 2048));
    const float ang = pos * inv; double sn, cs; dsincos((double)ang, sn, cs);
    float* rp = (float*)(p->ws + WS_ROPE) + (size_t)pi_ * 64; rp[j] = (float)cs; rp[32 + j] = (float)sn;
  }
  rms_rows<false, true>(cx, p->in[I_XP], p->in[I_XS], p->in[I_NMIX], (bf16_t*)(p->ws + WS_HA), nullptr, (float*)(p->ws + WS_XRES));
}

__device__ __forceinline__ float tanh_(float x) { return 1.0f - 2.0f / (1.0f + __expf(2.0f * x)); }
__device__ void rwkv_prep(KP p, const Ctx cx, int l, float* lds) {
  float* pm = lds; float* act = lds + 16384;
  const float* proj = (const float*)(p->ws + WS_PROJ); float* rec = (float*)(p->ws + WS_REC); float* gate = (float*)(p->ws + WS_GATE);
  const float* mu = p->in[I_RWMU] + l * 1024; const float* ww2 = p->in[I_RWW2] + (size_t)l * 64 * 256; const float* wa2 = p->in[I_RWA2] + (size_t)l * 64 * 256;
  const float* wg2 = p->in[I_RWG2] + (size_t)l * 128 * 256;
  const int tid = cx.tid;
  for (int tile = cx.bid; tile < T_ALL / 16; tile += cx.G) {
    const int t0 = tile * 16;
    for (int idx = tid; idx < 16 * 256; idx += NTHR) {
      const int i = idx >> 8, c4 = (idx & 255) * 4, t = t0 + i;
      const float4 cur = *(const float4*)(proj + (size_t)t * INW + 2304 + c4);
      bool first, last;
      if (t < T_P) { first = (t & 2047) == 0; last = (t & 2047) == 2047; } else { first = ((t - T_P) & 7) == 0; last = ((t - T_P) & 7) == 7; }
      float4 prev;
      if (!first) prev = *(const float4*)(proj + (size_t)(t - 1) * INW + 2304 + c4);
      else if (t < T_P) { prev.x = 0.f; prev.y = 0.f; prev.z = 0.f; prev.w = 0.f; }
      else prev = *(const float4*)(p->in[I_SSHIFT] + ((size_t)l * 128 + ((t - T_P) >> 3)) * 1024 + c4);
      const float4 m = *(const float4*)(mu + c4);
      float4 o; o.x = cur.x + (prev.x - cur.x) * m.x; o.y = cur.y + (prev.y - cur.y) * m.y; o.z = cur.z + (prev.z - cur.z) * m.z; o.w = cur.w + (prev.w - cur.w) * m.w;
      *(float4*)(pm + i * 1024 + c4) = o;
      if (last) { float* dst = t < T_P ? p->out + O_PSH + ((size_t)l * 8 + (t >> 11)) * 1024 + c4 : p->out + O_SSH + ((size_t)l * 128 + ((t - T_P) >> 3)) * 1024 + c4; *(float4*)dst = cur; }
    }
    __syncthreads();
    for (int idx = tid; idx < 16 * 256; idx += NTHR) { const int i = idx >> 8, j = idx & 255; const float x = pm[i * 1024 + 768 + j];
      act[i * 256 + j] = j < 64 ? tanh_(x) : (j < 128 ? x : sigm(x)); }
    __syncthreads();
    const int c = tid & 255, th = tid >> 8, lane = tid & 63;
    float aw[8], aa[8], ag[8];
#pragma unroll
    for (int i = 0; i < 8; ++i) { aw[i] = 0.f; aa[i] = 0.f; ag[i] = 0.f; }
#pragma unroll 2
    for (int j = 0; j < 64; j += 4) {
      float w2[4], a2[4];
#pragma unroll
      for (int q = 0; q < 4; ++q) { w2[q] = ww2[(j + q) * 256 + c]; a2[q] = wa2[(j + q) * 256 + c]; }
#pragma unroll
      for (int i = 0; i < 8; ++i) { const float4 xw = *(const float4*)(act + (th * 8 + i) * 256 + j); const float4 xa = *(const float4*)(act + (th * 8 + i) * 256 + 64 + j);
        aw[i] += xw.x * w2[0] + xw.y * w2[1] + xw.z * w2[2] + xw.w * w2[3]; aa[i] += xa.x * a2[0] + xa.y * a2[1] + xa.z * a2[2] + xa.w * a2[3]; }
    }
#pragma unroll 2
    for (int j = 0; j < 128; j += 4) {
      float g2[4];
#pragma unroll
      for (int q = 0; q < 4; ++q) g2[q] = wg2[(j + q) * 256 + c];
#pragma unroll
      for (int i = 0; i < 8; ++i) { const float4 xg = *(const float4*)(act + (th * 8 + i) * 256 + 128 + j); ag[i] += xg.x * g2[0] + xg.y * g2[1] + xg.z * g2[2] + xg.w * g2[3]; }
    }
    const int head = c >> 6, cc = c & 63;
    const float w0 = p->in[I_RWW0][l * 256 + c], a0 = p->in[I_RWA0][l * 256 + c], kkc = p->in[I_RWKK][l * 256 + c], kac = p->in[I_RWKA][l * 256 + c];
#pragma unroll
    for (int i = 0; i < 8; ++i) { const int ti = th * 8 + i, t = t0 + ti;
      const float wv = w0 + aw[i]; const float decay = __expf(-0.6065306597126334f * sigm(wv)); const float iclr = sigm(a0 + aa[i]);
      const float k = pm[ti * 1024 + 256 + c]; const float kkv = k * kkc; const float n2 = wave_sum(kkv * kkv, lane); const float kkn = kkv / fmaxf(sqrtf(n2), 1e-12f);
      const float k2 = k * (1.0f + (iclr - 1.0f) * kac); const float r = pm[ti * 1024 + c], v = pm[ti * 1024 + 512 + c];
      float* rp = rec + ((size_t)head * T_ALL + t) * 384 + cc;
      rp[0] = decay; rp[64] = kkn; rp[128] = kkn * iclr; rp[192] = k2; rp[256] = r; rp[320] = v;
      gate[(size_t)t * 256 + c] = ag[i]; }
    __syncthreads();
  }
}

__device__ __forceinline__ bf16x8 make_cf(const float* src, float sg) {
  const float4 a = *(const float4*)src, b = *(const float4*)(src + 4);
  u32x4 cw; cw.x = pack2(sg * a.x, sg * a.y); cw.y = pack2(sg * a.z, sg * a.w); cw.z = pack2(sg * b.x, sg * b.y); cw.w = pack2(sg * b.z, sg * b.w);
  bf16x8 r; __builtin_memcpy(&r, &cw, 16); return r;
}
template <bool FULL>
__device__ void s5_units(KP p, const Ctx cx, int l, unsigned char* ldsraw) {
  const int tid = cx.tid, w = tid >> 6, lane = tid & 63, fr = lane & 15, kg = lane >> 4;
  float* ubuf = (float*)(ldsraw + w * 8704);
  bf16_t* Ht = (bf16_t*)(ldsraw + w * 8704 + 4096);
  const float* cst = (const float*)(p->ws + WS_S5C) + (size_t)l * 36864;
  const float* proj = (const float*)(p->ws + WS_PROJ); float* E = (float*)(p->ws + WS_S5E);
  float* ysf = (float*)(p->ws + WS_YSF); bf16_t* ysb = (bf16_t*)(p->ws + WS_YSB);
  const int nunits = FULL ? 4096 + 2048 : 4096, gw = cx.bid * 8 + w, nw = cx.G * 8;
  for (int unit = gw; unit < nunits; unit += nw) {
    const bool sample = unit >= 4096;
    int seq, g, c, tok0, nsteps;
    if (!sample) { seq = unit >> 9; g = (unit >> 5) & 15; c = unit & 31; tok0 = seq * 2048 + c * 64; nsteps = 64; }
    else { const int u2 = unit - 4096; seq = u2 >> 4; g = u2 & 15; c = 0; tok0 = T_P + seq * 8; nsteps = 8; }
    for (int idx = lane; idx < nsteps * 4; idx += 64) { const int s = idx >> 2, q = idx & 3; *(float4*)(ubuf + s * 16 + q * 4) = *(const float4*)(proj + (size_t)(tok0 + s) * INW + g * 16 + q * 4); }
    const int gp = g * 64 + lane;
    float bre[16], bim[16];
#pragma unroll
    for (int q = 0; q < 4; ++q) { const float4 a = *(const float4*)(cst + 4096 + gp * 16 + q * 4), b = *(const float4*)(cst + 4096 + 16384 + gp * 16 + q * 4);
      bre[q * 4] = a.x; bre[q * 4 + 1] = a.y; bre[q * 4 + 2] = a.z; bre[q * 4 + 3] = a.w; bim[q * 4] = b.x; bim[q * 4 + 1] = b.y; bim[q * 4 + 2] = b.z; bim[q * 4 + 3] = b.w; }
    const float lre = cst[gp], lim = cst[1024 + gp];
    float hre = 0.f, him = 0.f;
    if (FULL) {
      if (sample) { hre = p->in[I_S5RE][((size_t)l * 128 + seq) * 1024 + gp]; him = p->in[I_S5IM][((size_t)l * 128 + seq) * 1024 + gp]; }
      else { const float qre = cst[2048 + gp], qim = cst[3072 + gp];
#pragma unroll 4
        for (int j = 0; j < c; ++j) { const float ere = E[((size_t)((seq * 16 + g) * 32 + j) * 2 + 0) * 64 + lane], eim = E[((size_t)((seq * 16 + g) * 32 + j) * 2 + 1) * 64 + lane];
          const float nr = qre * hre - qim * him + ere, ni = qre * him + qim * hre + eim; hre = nr; him = ni; } }
    }
    bf16x8 cf0 = {0, 0, 0, 0, 0, 0, 0, 0}, cf1 = cf0, cf2 = cf0, cf3 = cf0; float dsk = 0.f;
    if (FULL) {
      const float* cre = p->in[I_CRE] + ((size_t)(l * 16 + g) * 16 + fr) * 64 + kg * 8; const float* cim = p->in[I_CIM] + ((size_t)(l * 16 + g) * 16 + fr) * 64 + kg * 8;
      cf0 = make_cf(cre, 1.f); cf1 = make_cf(cre + 32, 1.f); cf2 = make_cf(cim, -1.f); cf3 = make_cf(cim + 32, -1.f);
      dsk = p->in[I_S5D][(l * 16 + g) * 16 + fr];
    }
    for (int tile = 0; tile * 16 < nsteps; ++tile) {
#pragma unroll 4
      for (int s = 0; s < 16; ++s) {
        const int st = tile * 16 + s;
        if (st < nsteps) {
          float bur = 0.f, bui = 0.f;
#pragma unroll
          for (int q = 0; q < 4; ++q) { const float4 u = *(const float4*)(ubuf + st * 16 + q * 4);
            bur += bre[q * 4] * u.x + bre[q * 4 + 1] * u.y + bre[q * 4 + 2] * u.z + bre[q * 4 + 3] * u.w;
            bui += bim[q * 4] * u.x + bim[q * 4 + 1] * u.y + bim[q * 4 + 2] * u.z + bim[q * 4 + 3] * u.w; }
          const float nr = lre * hre - lim * him + bur, ni = lre * him + lim * hre + bui; hre = nr; him = ni;
        }
        if (FULL) { Ht[s * 136 + lane] = f2bf(hre); Ht[s * 136 + 64 + lane] = f2bf(him); }
      }
      if (FULL) {
        f32x4 acc = {0.f, 0.f, 0.f, 0.f};
        { const bf16_t* hp = Ht + fr * 136 + kg * 8;
          acc = __builtin_amdgcn_mfma_f32_16x16x32_bf16(*(const bf16x8*)(hp), cf0, acc, 0, 0, 0); acc = __builtin_amdgcn_mfma_f32_16x16x32_bf16(*(const bf16x8*)(hp + 32), cf1, acc, 0, 0, 0);
          acc = __builtin_amdgcn_mfma_f32_16x16x32_bf16(*(const bf16x8*)(hp + 64), cf2, acc, 0, 0, 0); acc = __builtin_amdgcn_mfma_f32_16x16x32_bf16(*(const bf16x8*)(hp + 96), cf3, acc, 0, 0, 0); }
#pragma unroll
        for (int j = 0; j < 4; ++j) { const int tt = tile * 16 + kg * 4 + j;
          if (tt < nsteps) { const float uval = ubuf[tt * 16 + fr]; float y = acc[j] + dsk * uval;
            const float in = 0.7978845608028654f * (y + 0.044715f * y * y * y); y = 0.5f * y * (1.0f + tanh_(in));
            const size_t o = (size_t)(tok0 + tt) * 256 + g * 16 + fr; ysf[o] = y; ysb[o] = f2bf(y); } }
      }
    }
    if (!FULL) { E[((size_t)((seq * 16 + g) * 32 + c) * 2 + 0) * 64 + lane] = hre; E[((size_t)((seq * 16 + g) * 32 + c) * 2 + 1) * 64 + lane] = him; }
    else if (sample) { p->out[O_SRE + ((size_t)l * 128 + seq) * 1024 + gp] = hre; p->out[O_SIM + ((size_t)l * 128 + seq) * 1024 + gp] = him; }
    else if (c == 31) { p->out[O_PRE + ((size_t)l * 8 + seq) * 1024 + gp] = hre; p->out[O_PIM + ((size_t)l * 8 + seq) * 1024 + gp] = him; }
  }
}

constexpr int STG = 13312, OFF_HG = 6144, OFF_RT = 10240;
__device__ void recur_phase(KP p, const Ctx cx, int l, float* lds) {
  const int tid = cx.tid, w = tid >> 6, lane = tid & 63, role = w >> 1, sub = w & 1;
  const float* proj = (const float*)(p->ws + WS_PROJ); const float* rec = (const float*)(p->ws + WS_REC); float* oraw = (float*)(p->ws + WS_ORAW);
  const float* lbl = p->in[I_LBLOG]; const float* rope = (const float*)(p->ws + WS_ROPE);
  for (int unit = cx.bid; unit < 256; unit += cx.G) {
    const int bseq = unit >> 5, head = (unit >> 3) & 3, rs = unit & 7;
    const int row = rs * 8 + sub * 4 + (lane >> 4), k4 = (lane & 15) * 4;
    float s0 = 0.f, s1 = 0.f, s2 = 0.f, s3 = 0.f;
    const float gam = 1.0f - exp2f(-5.0f - (float)head);
    const float* st_in = role == 0 ? p->in[I_SRW] : (role == 1 ? p->in[I_SHG] : p->in[I_SRT]);
    float* st_ps = p->out + (role == 0 ? O_PRW : (role == 1 ? O_PHG : O_PRT));
    float* st_ss = p->out + (role == 0 ? O_SRW : (role == 1 ? O_SHG : O_SRT));
    float4 rw0, rw1, rw2, hg0, hg1, rt0, rt1; rw0.x = rw0.y = rw0.z = rw0.w = 0.f; rw1 = rw0; rw2 = rw0; hg0 = rw0; hg1 = rw0; rt0 = rw0; rt1 = rw0;
    for (int it = -1; it < 136; ++it) {
      const int nx = it + 1;
      const int tbn = nx < 128 ? bseq * 2048 + nx * 16 : T_P + (bseq * 16 + (nx - 128) * 2) * 8;
      if (nx < 136) {
        { const float* rb = rec + ((size_t)head * T_ALL + tbn) * 384 + (size_t)tid * 4; rw0 = *(const float4*)rb; rw1 = *(const float4*)(rb + 2048); rw2 = *(const float4*)(rb + 4096); }
        { const int arr = tid >> 8, i = (tid & 255) >> 4, c4 = (tid & 15) * 4; hg0 = *(const float4*)(proj + (size_t)(tbn + i) * INW + 256 + arr * 256 + head * 64 + c4);
          if (tid < 256) hg1 = *(const float4*)(proj + (size_t)(tbn + i) * INW + 256 + 2 * 256 + head * 64 + c4); }
        if (tid < 256) { const int arr = tid >> 7, i = (tid & 127) >> 3, c4 = (tid & 7) * 4; const float* s = proj + (size_t)(tbn + i) * INW + 1280 + arr * 256 + head * 64 + c4;
          rt0 = *(const float4*)s; rt1 = *(const float4*)(s + 32); }
        else { const int i = (tid - 256) >> 4, c4 = (tid & 15) * 4; rt0 = *(const float4*)(proj + (size_t)(tbn + i) * INW + 1280 + 512 + head * 64 + c4); }
      }
      if (it >= 0) {
        const float* buf = lds + (it & 1) * STG;
        const int tb = it < 128 ? bseq * 2048 + it * 16 : T_P + (bseq * 16 + (it - 128) * 2) * 8;
        if (role < 3) {
#pragma unroll 1
          for (int half = 0; half < 2; ++half) {
            const int sseq = bseq * 16 + (it - 128) * 2 + half;
            if (it >= 128) {
              const float* sp = st_in + ((size_t)(l * 128 + sseq) * 4 + head) * 4096;
              if (role == 0) { const float4 v = *(const float4*)(sp + row * 64 + k4); s0 = v.x; s1 = v.y; s2 = v.z; s3 = v.w; }
              else { s0 = sp[(k4 + 0) * 64 + row]; s1 = sp[(k4 + 1) * 64 + row]; s2 = sp[(k4 + 2) * 64 + row]; s3 = sp[(k4 + 3) * 64 + row]; }
            }
            if (role == 0) {
#pragma unroll 2
              for (int ii = 0; ii < 8; ++ii) { const int i = half * 8 + ii; const float* b = buf + i * 384;
                const float4 wv = *(const float4*)(b + k4), kk = *(const float4*)(b + 64 + k4), ka = *(const float4*)(b + 128 + k4), kv = *(const float4*)(b + 192 + k4), rr = *(const float4*)(b + 256 + k4);
                const float vr = b[320 + row];
                const float sa = -row_sum16(s0 * kk.x + s1 * kk.y + s2 * kk.z + s3 * kk.w);
                s0 = s0 * wv.x + (sa * ka.x + vr * kv.x); s1 = s1 * wv.y + (sa * ka.y + vr * kv.y); s2 = s2 * wv.z + (sa * ka.z + vr * kv.z); s3 = s3 * wv.w + (sa * ka.w + vr * kv.w);
                const float y = row_sum16(s0 * rr.x + s1 * rr.y + s2 * rr.z + s3 * rr.w);
                if ((lane & 15) == 0) oraw[(size_t)(tb + i) * 768 + 512 + head * 64 + row] = y; }
            } else if (role == 1) {
#pragma unroll 2
              for (int ii = 0; ii < 8; ++ii) { const int i = half * 8 + ii; const float* b = buf + OFF_HG + i * 64;
                const float4 f = *(const float4*)(b + k4), ky = *(const float4*)(b + 1024 + k4), q = *(const float4*)(b + 2048 + k4); const float vr = b[3072 + row];
                s0 = f.x * s0 + ky.x * vr; s1 = f.y * s1 + ky.y * vr; s2 = f.z * s2 + ky.z * vr; s3 = f.w * s3 + ky.w * vr;
                const float y = row_sum16(s0 * q.x + s1 * q.y + s2 * q.z + s3 * q.w);
                if ((lane & 15) == 0) oraw[(size_t)(tb + i) * 768 + head * 64 + row] = y; }
            } else {
#pragma unroll 2
              for (int ii = 0; ii < 8; ++ii) { const int i = half * 8 + ii; const float* b = buf + OFF_RT + i * 64;
                const float4 ky = *(const float4*)(b + k4), q = *(const float4*)(b + 1024 + k4); const float vr = b[2048 + row];
                s0 = gam * s0 + ky.x * vr; s1 = gam * s1 + ky.y * vr; s2 = gam * s2 + ky.z * vr; s3 = gam * s3 + ky.w * vr;
                const float y = row_sum16(s0 * q.x + s1 * q.y + s2 * q.z + s3 * q.w);
                if ((lane & 15) == 0) oraw[(size_t)(tb + i) * 768 + 256 + head * 64 + row] = y; }
            }
            if (it >= 128 || (it == 127 && half == 1)) {
              float* dp = it >= 128 ? st_ss + ((size_t)(l * 128 + sseq) * 4 + head) * 4096 : st_ps + ((size_t)(l * 8 + bseq) * 4 + head) * 4096;
              if (role == 0) { float4 v; v.x = s0; v.y = s1; v.z = s2; v.w = s3; *(float4*)(dp + row * 64 + k4) = v; }
              else { dp[(k4 + 0) * 64 + row] = s0; dp[(k4 + 1) * 64 + row] = s1; dp[(k4 + 2) * 64 + row] = s2; dp[(k4 + 3) * 64 + row] = s3; }
            }
          }
        }
      }
      if (nx < 136) {
        float* nb = lds + (nx & 1) * STG;
        *(float4*)(nb + tid * 4) = rw0; *(float4*)(nb + 2048 + tid * 4) = rw1; *(float4*)(nb + 4096 + tid * 4) = rw2;
        { const int arr = tid >> 8, i = (tid & 255) >> 4, c4 = (tid & 15) * 4; const float4 x = hg0;
          if (arr == 0) { float4 o; o.x = siluf(x.x); o.y = siluf(x.y); o.z = siluf(x.z); o.w = siluf(x.w); *(float4*)(nb + OFF_HG + 2048 + i * 64 + c4) = o;
            *(float4*)(nb + OFF_HG + 3072 + i * 64 + c4) = hg1; }
          else { float4 lb; lb.x = 0.f; lb.y = 0.f; lb.z = 0.f; lb.w = 0.f;
            if (l > 0) { const float4 la = *(const float4*)(lbl + head * 64 + c4), lc = *(const float4*)(lbl + 256 + head * 64 + c4);
              lb.x = 1.0f / (1.0f + __expf(la.x - lc.x)); lb.y = 1.0f / (1.0f + __expf(la.y - lc.y)); lb.z = 1.0f / (1.0f + __expf(la.z - lc.z)); lb.w = 1.0f / (1.0f + __expf(la.w - lc.w)); }
            float4 f, ky;
            f.x = lb.x + (1.f - lb.x) * sigm(x.x); ky.x = (1.f - lb.x) * sigm(-x.x); f.y = lb.y + (1.f - lb.y) * sigm(x.y); ky.y = (1.f - lb.y) * sigm(-x.y);
            f.z = lb.z + (1.f - lb.z) * sigm(x.z); ky.z = (1.f - lb.z) * sigm(-x.z); f.w = lb.w + (1.f - lb.w) * sigm(x.w); ky.w = (1.f - lb.w) * sigm(-x.w);
            *(float4*)(nb + OFF_HG + i * 64 + c4) = f; *(float4*)(nb + OFF_HG + 1024 + i * 64 + c4) = ky; } }
        if (tid < 256) { const int arr = tid >> 7, i = (tid & 127) >> 3, c4 = (tid & 7) * 4;
          const int pidx = nx < 128 ? nx * 16 + i : 2048 + (i & 7);
          const float4 cs = *(const float4*)(rope + (size_t)pidx * 64 + c4), sn = *(const float4*)(rope + (size_t)pidx * 64 + 32 + c4);
          const float sc = arr == 1 ? 0.125f : 1.0f; const float4 a = rt0, b = rt1; float4 o1, o2;
          o1.x = (a.x * cs.x - b.x * sn.x) * sc; o2.x = (a.x * sn.x + b.x * cs.x) * sc; o1.y = (a.y * cs.y - b.y * sn.y) * sc; o2.y = (a.y * sn.y + b.y * cs.y) * sc;
          o1.z = (a.z * cs.z - b.z * sn.z) * sc; o2.z = (a.z * sn.z + b.z * cs.z) * sc; o1.w = (a.w * cs.w - b.w * sn.w) * sc; o2.w = (a.w * sn.w + b.w * cs.w) * sc;
          float* d = nb + OFF_RT + (arr == 1 ? 0 : 1024) + i * 64 + c4; *(float4*)d = o1; *(float4*)(d + 32) = o2; }
        else { const int i = (tid - 256) >> 4, c4 = (tid & 15) * 4; *(float4*)(nb + OFF_RT + 2048 + i * 64 + c4) = rt0; }
      }
      __syncthreads();
    }
  }
}

__device__ void mix_phase(KP p, const Ctx cx, int l) {
  const int lane = cx.tid & 63, gw = cx.bid * 8 + (cx.tid >> 6), nw = cx.G * 8, c = lane * 4, head = lane >> 4, cc = (lane & 15) * 4;
  const float* proj = (const float*)(p->ws + WS_PROJ); const float* rec = (const float*)(p->ws + WS_REC); const float* gate = (const float*)(p->ws + WS_GATE);
  const float* oraw = (const float*)(p->ws + WS_ORAW); const float* gluo = (const float*)(p->ws + WS_GLUO); bf16_t* mix = (bf16_t*)(p->ws + WS_MIX);
  const float* ysf = (const float*)(p->ws + WS_YSF); const float4 bgl = *(const float4*)(p->in[I_BGLU] + l * 256 + c);
  const float4 s5n = *(const float4*)(p->in[I_S5NORM] + l * 256 + c), hgn = *(const float4*)(p->in[I_HGNORM] + l * 256 + c);
  const float4 lng = *(const float4*)(p->in[I_RWLNG] + l * 256 + c), lnb = *(const float4*)(p->in[I_RWLNB] + l * 256 + c), rk = *(const float4*)(p->in[I_RWRK] + l * 256 + c);
  for (int t = gw; t < T_ALL; t += nw) {
    bf16_t* mrow = mix + (size_t)t * DM;
    { const float4 z = *(const float4*)(gluo + (size_t)t * 256 + c); const float4 yv = *(const float4*)(ysf + (size_t)t * 256 + c);
      float4 g; g.x = yv.x * sigm(z.x + bgl.x); g.y = yv.y * sigm(z.y + bgl.y); g.z = yv.z * sigm(z.z + bgl.z); g.w = yv.w * sigm(z.w + bgl.w);
      const float ss = wave_sum(g.x * g.x + g.y * g.y + g.z * g.z + g.w * g.w, lane);
      const float r = rsqrtf(ss * (1.0f / 256.0f) + 1e-6f); u32x2 w; w.x = pack2(g.x * r * s5n.x, g.y * r * s5n.y); w.y = pack2(g.z * r * s5n.z, g.w * r * s5n.w); *(u32x2*)(mrow + c) = w; }
    { const float4 o = *(const float4*)(oraw + (size_t)t * 768 + c); const float hs = row_sum16(o.x * o.x + o.y * o.y + o.z * o.z + o.w * o.w);
      const float r = rsqrtf(hs * (1.0f / 64.0f) + 1e-6f); const float4 gp = *(const float4*)(proj + (size_t)t * INW + 256 + 768 + c);
      u32x2 w; w.x = pack2(o.x * r * hgn.x * siluf(gp.x), o.y * r * hgn.y * siluf(gp.y)); w.y = pack2(o.z * r * hgn.z * siluf(gp.z), o.w * r * hgn.w * siluf(gp.w)); *(u32x2*)(mrow + 256 + c) = w; }
    { const float4 o = *(const float4*)(oraw + (size_t)t * 768 + 256 + c); const float hs = row_sum16(o.x * o.x + o.y * o.y + o.z * o.z + o.w * o.w);
      const float r = rsqrtf(hs * (1.0f / 64.0f) + 1e-6f); const float4 gp = *(const float4*)(proj + (size_t)t * INW + 1280 + 768 + c);
      u32x2 w; w.x = pack2(o.x * r * siluf(gp.x), o.y * r * siluf(gp.y)); w.y = pack2(o.z * r * siluf(gp.z), o.w * r * siluf(gp.w)); *(u32x2*)(mrow + 512 + c) = w; }
    { const float4 y = *(const float4*)(oraw + (size_t)t * 768 + 512 + c); const float mean = row_sum16(y.x + y.y + y.z + y.w) * (1.0f / 64.0f);
      const float dx = y.x - mean, dy = y.y - mean, dz = y.z - mean, dw = y.w - mean; const float var = row_sum16(dx * dx + dy * dy + dz * dz + dw * dw) * (1.0f / 64.0f);
      const float r = rsqrtf(var + 64e-5f);
      const float* rp = rec + ((size_t)head * T_ALL + t) * 384 + cc; const float4 k2 = *(const float4*)(rp + 192), rr = *(const float4*)(rp + 256), v = *(const float4*)(rp + 320);
      const float bonus = row_sum16(rr.x * k2.x * rk.x + rr.y * k2.y * rk.y + rr.z * k2.z * rk.z + rr.w * k2.w * rk.w);
      const float4 g = *(const float4*)(gate + (size_t)t * 256 + c);
      u32x2 w; w.x = pack2((dx * r * lng.x + lnb.x + bonus * v.x) * g.x, (dy * r * lng.y + lnb.y + bonus * v.y) * g.y);
      w.y = pack2((dz * r * lng.z + lnb.z + bonus * v.z) * g.z, (dw * r * lng.w + lnb.w + bonus * v.w) * g.w); *(u32x2*)(mrow + 768 + c) = w; }
  }
}

constexpr int KV_LD = 264;
__device__ __forceinline__ void load_kv_tile(const Ctx cx, const bf16_t* src, bf16_t* dst) {
  const int tid = cx.tid;
#pragma unroll 4
  for (int n = 0; n < 16; ++n) { const int idx = tid + n * 512, r = idx >> 5, c = (idx & 31) * 8; *(u32x4*)(dst + r * KV_LD + c) = *(const u32x4*)(src + r * 256 + c); }
}
__device__ void attn_prompt_unit(KP p, const Ctx cx, int l, int unit, unsigned char* ldsraw) {
  const int tid = cx.tid, w = tid >> 6, lane = tid & 63, fr = lane & 15, kg = lane >> 4;
  const int b = unit >> 6, head = (unit >> 4) & 3, qt = unit & 15;
  bf16_t* kv = (bf16_t*)ldsraw;
  const bf16_t* Kb = (const bf16_t*)(p->ws + WS_KB) + ((size_t)l * 32 + b * 4 + head) * 65536;
  const bf16_t* Vt = (const bf16_t*)(p->ws + WS_VT) + ((size_t)l * 32 + b * 4 + head) * 65536;
  const bf16_t* qb = (const bf16_t*)(p->ws + WS_QB); bf16_t* ob = (bf16_t*)(p->ws + WS_OB);
  const int tq = b * 2048 + qt * 128 + w * 16 + fr;
  load_kv_tile(cx, Kb, kv);
  bf16x8 qf[8];
#pragma unroll
  for (int ks = 0; ks < 8; ++ks) qf[ks] = *(const bf16x8*)(qb + (size_t)tq * DM + head * 256 + ks * 32 + kg * 8);
  __syncthreads();
  f32x4 sacc[16];
#pragma unroll
  for (int nt = 0; nt < 16; ++nt) { f32x4 a = {0.f, 0.f, 0.f, 0.f};
#pragma unroll
    for (int ks = 0; ks < 8; ++ks) { const bf16x8 kf = *(const bf16x8*)(kv + (nt * 16 + fr) * KV_LD + ks * 32 + kg * 8); a = __builtin_amdgcn_mfma_f32_16x16x32_bf16(kf, qf[ks], a, 0, 0, 0); }
    sacc[nt] = a; }
  float mx = -3.0e38f;
#pragma unroll
  for (int nt = 0; nt < 16; ++nt) mx = fmaxf(mx, fmaxf(fmaxf(sacc[nt][0], sacc[nt][1]), fmaxf(sacc[nt][2], sacc[nt][3])));
  mx = fmaxf(mx, shx(mx, 16, lane)); mx = fmaxf(mx, shx(mx, 32, lane));
  float sum = 0.f; bf16x8 pf[8];
#pragma unroll
  for (int k2 = 0; k2 < 8; ++k2) {
    float e[8];
#pragma unroll
    for (int j = 0; j < 4; ++j) { e[j] = __expf((sacc[2 * k2][j] - mx) * 0.0625f); e[4 + j] = __expf((sacc[2 * k2 + 1][j] - mx) * 0.0625f); }
#pragma unroll
    for (int j = 0; j < 8; ++j) { sum += e[j]; pf[k2][j] = (short)f2bf(e[j]); }
  }
  sum += shx(sum, 16, lane); sum += shx(sum, 32, lane);
  const float inv = 1.0f / sum;
  __syncthreads();
  load_kv_tile(cx, Vt, kv);
  __syncthreads();
#pragma unroll 1
  for (int dt = 0; dt < 16; ++dt) { f32x4 a = {0.f, 0.f, 0.f, 0.f};
#pragma unroll
    for (int k2 = 0; k2 < 8; ++k2) { const bf16_t* vp = kv + (dt * 16 + fr) * KV_LD + k2 * 32 + kg * 4;
      const u32x2 lo = *(const u32x2*)vp, hi = *(const u32x2*)(vp + 16); u32x4 vv; vv.x = lo.x; vv.y = lo.y; vv.z = hi.x; vv.w = hi.y;
      bf16x8 vf; __builtin_memcpy(&vf, &vv, 16);
      a = __builtin_amdgcn_mfma_f32_16x16x32_bf16(vf, pf[k2], a, 0, 0, 0); }
    u32x2 wv; wv.x = pack2(a[0] * inv, a[1] * inv); wv.y = pack2(a[2] * inv, a[3] * inv);
    *(u32x2*)(ob + (size_t)tq * DM + head * 256 + dt * 16 + kg * 4) = wv; }
  __syncthreads();
}

__device__ void attn_sample_unit(KP p, const Ctx cx, int l, int unit, unsigned char* ldsraw) {
  const int tid = cx.tid, w = tid >> 6, lane = tid & 63;
  const int b = unit >> 2, head = unit & 3;
  float* qs = (float*)ldsraw;
  float* S = qs + 2048;
  float* Pt = S + 2048;
  float* red = Pt + 2048;
  const bf16_t* qb = (const bf16_t*)(p->ws + WS_QB); bf16_t* ob = (bf16_t*)(p->ws + WS_OB);
  const float* Kc = p->in[I_CK] + ((size_t)(l * 128 + b) * 256) * 1024 + head * 256;
  const float* Vc = p->in[I_CV] + ((size_t)(l * 128 + b) * 256) * 1024 + head * 256;
  const int t0 = T_P + b * 8;
  for (int idx = tid; idx < 2048; idx += NTHR) qs[idx] = bf2f(qb[(size_t)(t0 + (idx >> 8)) * DM + head * 256 + (idx & 255)]);
  __syncthreads();
  float4 q[8];
#pragma unroll
  for (int i = 0; i < 8; ++i) q[i] = *(const float4*)(qs + i * 256 + lane * 4);
#pragma unroll 1
  for (int kb = 0; kb < 4; ++kb) {
    float v[64];
#pragma unroll
    for (int kk = 0; kk < 8; ++kk) { const float4 kx = *(const float4*)(Kc + (size_t)(w * 32 + kb * 8 + kk) * 1024 + lane * 4);
#pragma unroll
      for (int i = 0; i < 8; ++i) v[kk * 8 + i] = kx.x * q[i].x + kx.y * q[i].y + kx.z * q[i].z + kx.w * q[i].w; }
#pragma unroll
    for (int off = 32; off >= 1; off >>= 1) { const bool up = (lane & off) != 0;
#pragma unroll
      for (int i = 0; i < off; ++i) { const float send = up ? v[i] : v[i + off]; const float keep = up ? v[i + off] : v[i]; v[i] = keep + shx(send, off, lane); } }
    S[(lane & 7) * 256 + w * 32 + kb * 8 + (lane >> 3)] = v[0];
  }
  __syncthreads();
  { const float4 s = *(const float4*)(S + w * 256 + lane * 4); const float mx = wave_max(fmaxf(fmaxf(s.x, s.y), fmaxf(s.z, s.w)), lane);
    const float e0 = __expf((s.x - mx) * 0.0625f), e1 = __expf((s.y - mx) * 0.0625f), e2 = __expf((s.z - mx) * 0.0625f), e3 = __expf((s.w - mx) * 0.0625f);
    const float inv = 1.0f / wave_sum(e0 + e1 + e2 + e3, lane);
    Pt[(lane * 4 + 0) * 8 + w] = e0 * inv; Pt[(lane * 4 + 1) * 8 + w] = e1 * inv; Pt[(lane * 4 + 2) * 8 + w] = e2 * inv; Pt[(lane * 4 + 3) * 8 + w] = e3 * inv; }
  __syncthreads();
  float4 acc[8];
#pragma unroll
  for (int i = 0; i < 8; ++i) { acc[i].x = 0.f; acc[i].y = 0.f; acc[i].z = 0.f; acc[i].w = 0.f; }
#pragma unroll 4
  for (int kk = 0; kk < 32; ++kk) { const int m = w * 32 + kk; const float4 vx = *(const float4*)(Vc + (size_t)m * 1024 + lane * 4);
    const float4 p0 = *(const float4*)(Pt + m * 8), p1 = *(const float4*)(Pt + m * 8 + 4); const float pr[8] = {p0.x, p0.y, p0.z, p0.w, p1.x, p1.y, p1.z, p1.w};
#pragma unroll
    for (int i = 0; i < 8; ++i) { acc[i].x += pr[i] * vx.x; acc[i].y += pr[i] * vx.y; acc[i].z += pr[i] * vx.z; acc[i].w += pr[i] * vx.w; } }
#pragma unroll
  for (int i = 0; i < 8; ++i) *(float4*)(red + (w * 8 + i) * 256 + lane * 4) = acc[i];
  __syncthreads();
  { const int i = tid >> 6; float4 s; s.x = 0.f; s.y = 0.f; s.z = 0.f; s.w = 0.f;
#pragma unroll
    for (int ww = 0; ww < 8; ++ww) { const float4 r = *(const float4*)(red + (ww * 8 + i) * 256 + lane * 4); s.x += r.x; s.y += r.y; s.z += r.z; s.w += r.w; }
    u32x2 o; o.x = pack2(s.x, s.y); o.y = pack2(s.z, s.w); *(u32x2*)(ob + (size_t)(t0 + i) * DM + head * 256 + lane * 4) = o; }
  __syncthreads();
}

constexpr int NPHASE = 29;
__global__ void __launch_bounds__(512) mega(Params p_) {
  extern __shared__ __attribute__((aligned(16))) unsigned char lds[];
  cg::grid_group grid = cg::this_grid();
  LAS unsigned char* gl = (LAS unsigned char*)lds;
  const int ph_lo = p_.ph_lo, ph_hi = p_.ph_hi;
  const int wid0 = __builtin_amdgcn_readfirstlane((int)threadIdx.x >> 6);
#ifndef PH_MASK
#define PH_MASK 0xFFFF
#endif
#define PHON(x) ((PH_MASK >> (x)) & 1)
#define MK_CTX() Ctx cx; { int ln_; asm volatile("v_mbcnt_lo_u32_b32 %0, -1, 0\n\tv_mbcnt_hi_u32_b32 %0, -1, %0" : "=v"(ln_)); cx.tid = wid0 * 64 + ln_; } cx.bid = blockIdx.x; cx.G = gridDim.x; asm volatile("" : "+s"(cx.bid), "+s"(cx.G));
  int ph = ph_lo;
  if (ph == 0) {
    KP p = get_params(); MK_CTX();
    if (PHON(14)) phase_prep(p, cx, lds);
    ph = 1; if (ph < ph_hi) grid.sync();
  }
  for (; ph < ph_hi; ++ph) {
    KP p = get_params(); MK_CTX();
    {
      const int l = (ph - 1) / 14, s = (ph - 1) % 14;
      unsigned char* wl = p->ws + WS_WT + (size_t)l * WL_SIZE;
      bf16_t* hA = (bf16_t*)(p->ws + WS_HA); float* xres = (float*)(p->ws + WS_XRES);
      if (s == 0 && PHON(0)) {
        { EpiStoreF32 E{(float*)(p->ws + WS_PROJ), INW}; run_gemm(cx, gl, hA, (const bf16_t*)(wl + WL_IN), T_ALL, INW, DM, E, cx.bid); }
        const bf16_t* memb = (const bf16_t*)(p->ws + WS_MEMB);
        { EpiMemK E{p->out + O_PMK + (size_t)l * 2097152, (bf16_t*)(p->ws + WS_KB) + (size_t)l * 32 * 65536}; run_gemm(cx, gl, memb, (const bf16_t*)(wl + WL_K), 2048, DM, DM, E, (cx.bid + cx.G - 128 % cx.G) % cx.G); }
        { EpiStoreF32 E{p->out + O_PMV + (size_t)l * 2097152, DM}; run_gemm(cx, gl, memb, (const bf16_t*)(wl + WL_V), 2048, DM, DM, E, (cx.bid + cx.G - 160 % cx.G) % cx.G); }
        { EpiVt E{(bf16_t*)(p->ws + WS_VT) + (size_t)l * 32 * 65536}; run_gemm(cx, gl, (const bf16_t*)(wl + WL_V), memb, DM, 2048, DM, E, (cx.bid + cx.G - 192 % cx.G) % cx.G); }
      } else if (s == 1 && PHON(1)) {
        rwkv_prep(p, cx, l, (float*)lds);
        s5_units<false>(p, cx, l, lds);
      } else if (s == 2 && PHON(2)) {
#ifndef NO_RECUR
        recur_phase(p, cx, l, (float*)lds);
#endif
#ifndef NO_S5B
        s5_units<true>(p, cx, l, lds);
#endif
      } else if (s == 3 && PHON(3)) {
        EpiStoreF32 E{(float*)(p->ws + WS_GLUO), 256};
        run_gemm(cx, gl, (const bf16_t*)(p->ws + WS_YSB), (const bf16_t*)(wl + WL_GLU), T_ALL, 256, 256, E, cx.bid);
      } else if (s == 4 && PHON(4)) {
        mix_phase(p, cx, l);
      } else if ((s == 5 || s == 9 || s == 12) && PHON(5)) {
        const bf16_t* A = s == 5 ? (const bf16_t*)(p->ws + WS_MIX) : (s == 9 ? (const bf16_t*)(p->ws + WS_OB) : (const bf16_t*)(p->ws + WS_HID));
        const bf16_t* Bt = (const bf16_t*)(wl + (s == 5 ? WL_OUT : (s == 9 ? WL_O : WL_DOWN)));
        EpiRes E{xres}; run_gemm(cx, gl, A, Bt, T_ALL, DM, s == 12 ? DFF : DM, E, cx.bid);
      } else if ((s == 6 || s == 10) && PHON(6)) {
        rms_rows<false, false>(cx, xres, xres + (size_t)T_P * DM, (s == 6 ? p->in[I_NMEM] : p->in[I_NFFN]) + l * DM, hA, nullptr, nullptr);
      } else if (s == 7 && PHON(7)) {
        EpiBf<0> E{(bf16_t*)(p->ws + WS_QB), DM}; run_gemm(cx, gl, hA, (const bf16_t*)(wl + WL_Q), T_ALL, DM, DM, E, cx.bid);
      } else if (s == 8 && PHON(8)) {
        for (int u = cx.bid; u < 1024; u += cx.G) { if (u < 512) attn_prompt_unit(p, cx, l, u, lds); else attn_sample_unit(p, cx, l, u - 512, lds); }
      } else if (s == 11 && PHON(11)) {
        EpiBf<1> E{(bf16_t*)(p->ws + WS_HID), DFF}; run_gemm(cx, gl, hA, (const bf16_t*)(wl + WL_UP), T_ALL, DFF, DM, E, cx.bid);
      } else if (s == 13 && PHON(13)) {
        if (l == 0) rms_rows<false, false>(cx, xres, xres + (size_t)T_P * DM, p->in[I_NMIX] + DM, hA, nullptr, nullptr);
        else rms_rows<true, false>(cx, xres, xres + (size_t)T_P * DM, p->in[I_NFINAL], nullptr, p->out + O_Y, nullptr);
      }
    }
    if (ph + 1 < ph_hi) grid.sync();
  }
}

extern "C" void kernel_launch(void* const* d_in, const int* in_sizes, int n_in, void* d_out, int out_size, void* d_ws, size_t ws_size, hipStream_t stream) {
  static int grid_blocks = 0;
  if (!grid_blocks) {
    int dev = 0, cus = 0, per_cu = 0;
    (void)hipGetDevice(&dev);
    (void)hipDeviceGetAttribute(&cus, hipDeviceAttributeMultiprocessorCount, dev);
    (void)hipFuncSetAttribute((const void*)mega, hipFuncAttributeMaxDynamicSharedMemorySize, LDS_BYTES);
    (void)hipOccupancyMaxActiveBlocksPerMultiprocessor(&per_cu, (const void*)mega, NTHR, LDS_BYTES);
    if (per_cu < 1) per_cu = 1;
    grid_blocks = cus * per_cu;
    if (n_in != 47 || (size_t)out_size != O_END || ws_size < WS_END) fprintf(stderr, "kernel_launch: unexpected sizes n_in %d out %d ws %zu (need %zu)\n", n_in, out_size, ws_size, (size_t)WS_END);
  }
  Params p{};
  for (int i = 0; i < 47; ++i) p.in[i] = (const float*)d_in[i];
  p.out = (float*)d_out; p.ws = (unsigned char*)d_ws; p.ph_lo = 0; p.ph_hi = NPHASE;
  void* args[] = {&p};
  hipError_t e = hipLaunchCooperativeKernel((const void*)mega, dim3(grid_blocks), dim3(NTHR), args, LDS_BYTES, stream);
  if (e != hipSuccess) fprintf(stderr, "cooperative launch failed: %s (grid %d)\n", hipGetErrorString(e), grid_blocks);
}
```

```cpp
#include <hip/hip_runtime.h>
#include <hip/hip_cooperative_groups.h>
#include <cstdio>
namespace cg = cooperative_groups;

#define LAS __attribute__((address_space(3)))
typedef unsigned short bf16_t;
typedef float f32x2 __attribute__((ext_vector_type(2)));
typedef unsigned u32x2 __attribute__((ext_vector_type(2)));

constexpr int T_ALL = 17408, T_P = 16384, T_S = 1024, DM = 1024, INW = 3328, DFF = 4096;
constexpr int NTHR = 512;
constexpr int LDS_MAIN = 147456, LDS_BYTES = LDS_MAIN + 16;

constexpr size_t al(size_t x) { return (x + 255) & ~(size_t)255; }
constexpr size_t SZ_WIN = (size_t)INW * DM * 2, SZ_SQ = (size_t)DM * DM * 2, SZ_UP = (size_t)DFF * DM * 2, SZ_GLU = 256 * 256 * 2;
constexpr size_t WL_IN = 0, WL_OUT = WL_IN + SZ_WIN, WL_Q = WL_OUT + SZ_SQ, WL_K = WL_Q + SZ_SQ, WL_V = WL_K + SZ_SQ, WL_O = WL_V + SZ_SQ,
                 WL_UP = WL_O + SZ_SQ, WL_DOWN = WL_UP + SZ_UP, WL_GLU = WL_DOWN + SZ_UP, WL_SIZE = WL_GLU + SZ_GLU;
constexpr size_t WS_WT = 0;
constexpr size_t WS_MEMB = al(WS_WT + 2 * WL_SIZE);
constexpr size_t WS_XRES = al(WS_MEMB + (size_t)2048 * DM * 2);
constexpr size_t WS_HA = al(WS_XRES + (size_t)T_ALL * DM * 4);
constexpr size_t WS_MIX = al(WS_HA + (size_t)T_ALL * DM * 2);
constexpr size_t WS_QB = al(WS_MIX + (size_t)T_ALL * DM * 2);
constexpr size_t WS_OB = al(WS_QB + (size_t)T_ALL * DM * 2);
constexpr size_t WS_HID = al(WS_OB + (size_t)T_ALL * DM * 2);
constexpr size_t WS_PROJ = al(WS_HID + (size_t)T_ALL * DFF * 2);
constexpr size_t WS_REC = al(WS_PROJ + (size_t)T_ALL * INW * 2);
constexpr size_t WS_GATE = al(WS_REC + (size_t)T_ALL * 1536 * 4);
constexpr size_t WS_ORAW = al(WS_GATE + (size_t)T_ALL * 256 * 4);
constexpr size_t WS_YSF = al(WS_ORAW + (size_t)T_ALL * 768 * 4);
constexpr size_t WS_YSB = al(WS_YSF + (size_t)T_ALL * 256 * 4);
constexpr size_t WS_GLUO = al(WS_YSB + (size_t)T_ALL * 256 * 2);
constexpr size_t WS_S5E = al(WS_GLUO + (size_t)T_ALL * 256 * 4);
constexpr size_t WS_S5C = al(WS_S5E + (size_t)8 * 16 * 32 * 128 * 4);
constexpr size_t WS_ROPE = al(WS_S5C + (size_t)2 * 36864 * 4);
constexpr size_t WS_LB = al(WS_ROPE + (size_t)2056 * 64 * 4);
constexpr size_t WS_KB = al(WS_LB + 2 * 256 * 4);
constexpr size_t WS_VT = al(WS_KB + (size_t)2 * 32 * 65536 * 2);
constexpr size_t WS_BAR = al(WS_VT + (size_t)2 * 32 * 65536 * 2);
constexpr size_t WS_LORA = al(WS_BAR + 16384);
constexpr size_t WS_PART = al(WS_LORA + 2 * 65536 * 2);
constexpr size_t WS_END = al(WS_PART + (size_t)16 * T_S * DM * 4);

constexpr size_t O_Y = 0;
constexpr size_t O_PRE = (size_t)T_ALL * DM;
constexpr size_t O_PIM = O_PRE + 16384;
constexpr size_t O_PHG = O_PIM + 16384;
constexpr size_t O_PRT = O_PHG + 262144;
constexpr size_t O_PRW = O_PRT + 262144;
constexpr size_t O_PSH = O_PRW + 262144;
constexpr size_t O_PMK = O_PSH + 16384;
constexpr size_t O_PMV = O_PMK + 4194304;
constexpr size_t O_SRE = O_PMV + 4194304;
constexpr size_t O_SIM = O_SRE + 262144;
constexpr size_t O_SHG = O_SIM + 262144;
constexpr size_t O_SRT = O_SHG + 4194304;
constexpr size_t O_SRW = O_SRT + 4194304;
constexpr size_t O_SSH = O_SRW + 4194304;
constexpr size_t O_END = O_SSH + 262144;

struct Params {
  const float* in[47];
  float* out;
  unsigned char* ws;
  int ph_lo, ph_hi;
};

enum { I_XP = 0, I_XS, I_MEM, I_S5RE, I_S5IM, I_SHG, I_SRT, I_SRW, I_SSHIFT, I_CK, I_CV, I_NMIX, I_WIN, I_WOUT, I_LAMRE, I_LAMIM,
       I_BRE, I_BIM, I_CRE, I_CIM, I_S5D, I_LOGSTEP, I_WGLU, I_BGLU, I_S5NORM, I_LBLOG, I_HGNORM, I_RWMU, I_RWW0, I_RWW2, I_RWA0,
       I_RWA2, I_RWG2, I_RWKK, I_RWKA, I_RWRK, I_RWLNG, I_RWLNB, I_NMEM, I_WQ, I_WK, I_WV, I_WO, I_NFFN, I_WUP, I_WDOWN, I_NFINAL };

__device__ __forceinline__ unsigned short f2bf(float f) { unsigned u = __float_as_uint(f); u += 0x7FFFu + ((u >> 16) & 1u); return (unsigned short)(u >> 16); }
__device__ __forceinline__ unsigned pack2(float lo, float hi) { return (unsigned)f2bf(lo) | ((unsigned)f2bf(hi) << 16); }
__device__ __forceinline__ float bf2f(unsigned short b) { return __uint_as_float(((unsigned)b) << 16); }
__device__ __forceinline__ float4 ld4(const bf16_t* q) { const u32x2 v = *(const u32x2*)q; float4 r; r.x = __uint_as_float(v.x << 16); r.y = __uint_as_float(v.x & 0xffff0000u); r.z = __uint_as_float(v.y << 16); r.w = __uint_as_float(v.y & 0xffff0000u); return r; }
__device__ __forceinline__ float4 cv4(const u32x2 v) { float4 r; r.x = __uint_as_float(v.x << 16); r.y = __uint_as_float(v.x & 0xffff0000u); r.z = __uint_as_float(v.y << 16); r.w = __uint_as_float(v.y & 0xffff0000u); return r; }
__device__ __forceinline__ float sigm(float x) { return __builtin_amdgcn_rcpf(1.0f + __expf(-x)); }
__device__ __forceinline__ float siluf(float x) { return x * sigm(x); }
__device__ __forceinline__ float row_sum16(float x) {
  x += __int_as_float(__builtin_amdgcn_update_dpp(0, __float_as_int(x), 0x128, 0xf, 0xf, false));
  x += __int_as_float(__builtin_amdgcn_update_dpp(0, __float_as_int(x), 0x124, 0xf, 0xf, false));
  x += __int_as_float(__builtin_amdgcn_update_dpp(0, __float_as_int(x), 0x122, 0xf, 0xf, false));
  x += __int_as_float(__builtin_amdgcn_update_dpp(0, __float_as_int(x), 0x121, 0xf, 0xf, false));
  return x;
}
__device__ __forceinline__ float shx(float x, int off, int lane) { return __int_as_float(__builtin_amdgcn_ds_bpermute((lane ^ off) << 2, __float_as_int(x))); }
__device__ __forceinline__ float wave_sum(float x, int lane) { x = row_sum16(x); x += shx(x, 16, lane); x += shx(x, 32, lane); return x; }
__device__ __forceinline__ float wave_max(float x, int lane) {
#pragma unroll
  for (int o = 32; o >= 1; o >>= 1) x = fmaxf(x, shx(x, o, lane));
  return x;
}
__device__ __forceinline__ void dsincos(double x, double& s, double& c) {
  const double n = rint(x * 0.15915494309189535);
  double r = (x - n * 6.283185307179586) * 0.125;
  const double r2 = r * r;
  double sn = r * (1.0 - r2 / 6.0 * (1.0 - r2 / 20.0 * (1.0 - r2 / 42.0 * (1.0 - r2 / 72.0 * (1.0 - r2 / 110.0 * (1.0 - r2 / 156.0))))));
  double cs = 1.0 - r2 / 2.0 * (1.0 - r2 / 12.0 * (1.0 - r2 / 30.0 * (1.0 - r2 / 56.0 * (1.0 - r2 / 90.0 * (1.0 - r2 / 132.0)))));
#pragma unroll
  for (int i = 0; i < 3; ++i) { const double s2 = 2.0 * sn * cs, c2 = 1.0 - 2.0 * sn * sn; sn = s2; cs = c2; }
  s = sn; c = cs;
}

typedef const __attribute__((address_space(4))) Params* KP;
__device__ __forceinline__ KP get_params() { KP k = (KP)__builtin_amdgcn_kernarg_segment_ptr(); asm volatile("" : "+s"(k)); return k; }
namespace pg8 {
#define PG8_LAS __attribute__((address_space(3)))
typedef unsigned short bf16_t;
typedef short bf16x8 __attribute__((ext_vector_type(8)));
typedef float f32x4 __attribute__((ext_vector_type(4)));
typedef unsigned u32x4 __attribute__((ext_vector_type(4)));
constexpr int BM = 256, BK = 64, HALF = 128, HTB = HALF * BK * 2  , STAGE_BYTES = 8 * HTB, NXCD = 8, WGM = 8;

__host__ __device__ __forceinline__ int lds_byte(int r, int c) { const int st = (r >> 4) * 2 + (c >> 5), rr = r & 15, cc = c & 31, ob = rr * 64 + cc * 2; return st * 1024 + (ob ^ (((ob >> 9) & 1) << 5)); }
__host__ __device__ __forceinline__ void stage_rc(int b, int& R, int& C) { const int st = b / 1024, sb = b % 1024, swz = sb ^ (((sb >> 9) & 1) << 5); R = (st >> 1) * 16 + swz / 64; C = (st & 1) * 32 + (swz % 64) / 2; }
__host__ __device__ __forceinline__ int perm32(int rho) { const int n = rho >> 4, i = rho & 15; return 8 * (i >> 2) + 4 * n + (i & 3); }

struct Unit { int pm, pn; };
struct Gemm { const bf16_t* A; const bf16_t* Bt; int M, N, K, ld; };

struct StaticOrder {
    int nM, nN, nwg, G, c;
    __host__ __device__ void init(int M, int N, int G_, int c_) { nM = M / BM; nN = N / BM; nwg = nM * nN; G = G_; c = c_; }
    __host__ __device__ bool next(int i, Unit& u) const {
        const long L = (long)i * G + c; if (L >= nwg) return false;
        int wgid = (int)L; { const int q = nwg / NXCD, r = nwg % NXCD, xcd = wgid % NXCD, off = wgid / NXCD; wgid = (xcd < r ? xcd * (q + 1) : r * (q + 1) + (xcd - r) * q) + off; }
        const int nig = WGM * nN, gid = wgid / nig, fm = gid * WGM, gsz = (nM - fm) < WGM ? (nM - fm) : WGM;
        u.pm = fm + ((wgid % nig) % gsz); u.pn = (wgid % nig) / gsz; return true;
    }
    __device__ __forceinline__ void a_ready(const Unit&) const {}
    __device__ __forceinline__ void done(const Unit&) const {}
};
__device__ __forceinline__ unsigned cvt_pk_bf16(float lo, float hi) { unsigned r; asm volatile("v_cvt_pk_bf16_f32 %0, %1, %2" : "=v"(r) : "v"(lo), "v"(hi)); return r; }
typedef float f32x2 __attribute__((ext_vector_type(2)));
__device__ __forceinline__ f32x2 gelu_pk(f32x2 v) {
    const f32x2 av = __builtin_elementwise_abs(v), d = av * 0.2316418882f + 1.0f;
    f32x2 t; t.x = __builtin_amdgcn_rcpf(d.x); t.y = __builtin_amdgcn_rcpf(d.y);
    f32x2 q = t * 0.5307027145f + (-0.7265760135f); q = q * t + 0.7107068705f; q = q * t + (-0.142248368f); q = q * t + 0.127414796f; q = q * t;
    const f32x2 s = (v * v) * (-0.72134752044f);
    f32x2 e; e.x = __builtin_amdgcn_exp2f(s.x); e.y = __builtin_amdgcn_exp2f(s.y);
    const f32x2 m = v * (q * e), r = v - m;
    f32x2 o; o.x = v.x < 0.f ? m.x : r.x; o.y = v.y < 0.f ? m.y : r.y; return o;
}
template <class Epi, class Sched>
__device__ __forceinline__ void gemm_phase(PG8_LAS unsigned char* lds, const Gemm g, const Sched& S, const Epi& E, const int tid_in) {
    const int tid = tid_in, wid = __builtin_amdgcn_readfirstlane(tid >> 6), lane = tid & 63, wr = wid >> 2, wc = wid & 3, fr = lane & 15, fq = lane >> 4;
    const int K = g.K, nt = K / BK, LD = g.ld;
    unsigned voffA[2], voffB[2];
#pragma unroll
    for (int i = 0; i < 2; ++i) { int R, C; stage_rc(tid * 16 + i * 8192, R, C); const int Rb = Epi::PERM ? ((R & ~31) + perm32(R & 31)) : R;
        voffA[i] = (unsigned)(R * LD + C) * 2u; voffB[i] = (unsigned)(Rb * LD + C) * 2u; }
    const size_t kstep = (size_t)(BK * 2);
    const size_t hstep = (size_t)HALF * LD * 2;
    const size_t tstep = 2 * hstep;
    const unsigned ldsw = (unsigned)wid * 1024u;
    const int aoff = lds_byte(wr * 64 + fr, fq * 8), boff = lds_byte(wc * 32 + fr, fq * 8);
#define PG8_SA(b, h) (((b) * 2 + (h)) * HTB)
#define PG8_SB(b, h) ((4 + (b) * 2 + (h)) * HTB)
#define PG8_STAGE(bufoff, gbase, voff) do { _Pragma("unroll") for (int _i = 0; _i < 2; ++_i) \
        __builtin_amdgcn_global_load_lds((const unsigned*)((const char*)(gbase) + (voff)[_i]), (PG8_LAS unsigned*)(lds + (bufoff) + ldsw + _i * 8192), 16, 0, 0); } while (0)
#define PG8_LDA(dst, b, h) do { _Pragma("unroll") for (int m = 0; m < 4; ++m) _Pragma("unroll") for (int k = 0; k < 2; ++k) dst[m][k] = *(const PG8_LAS bf16x8*)(lds + PG8_SA(b, h) + aoff + m * 2048 + k * 1024); } while (0)
#define PG8_LDB(dst, b, h) do { _Pragma("unroll") for (int n = 0; n < 2; ++n) _Pragma("unroll") for (int k = 0; k < 2; ++k) dst[n][k] = *(const PG8_LAS bf16x8*)(lds + PG8_SB(b, h) + boff + n * 2048 + k * 1024); } while (0)
#define PG8_MMA(ai, bj, At, Bt) do { __builtin_amdgcn_s_setprio(1); _Pragma("unroll") for (int m = 0; m < 4; ++m) _Pragma("unroll") for (int n = 0; n < 2; ++n) _Pragma("unroll") for (int k = 0; k < 2; ++k) \
        acc[ai][bj][m][n] = __builtin_amdgcn_mfma_f32_16x16x32_bf16(Bt[n][k], At[m][k], acc[ai][bj][m][n], 0, 0, 0); __builtin_amdgcn_s_setprio(0); } while (0)
#define PG8_WAIT_V(n) asm volatile("s_waitcnt vmcnt(" #n ")" ::: "memory")
#define PG8_WAIT_L(n) asm volatile("s_waitcnt lgkmcnt(" #n ")" ::: "memory")
#define PG8_BAR __builtin_amdgcn_s_barrier()
#define PG8_SCHED __builtin_amdgcn_sched_barrier(0)
    Unit cur, nxt; int ui = 0;
    if (!S.next(0, cur)) return;
    f32x4 acc[2][2][4][2];
#pragma unroll
    for (int a = 0; a < 2; ++a)
#pragma unroll
        for (int b = 0; b < 2; ++b)
#pragma unroll
            for (int m = 0; m < 4; ++m)
#pragma unroll
                for (int n = 0; n < 2; ++n) acc[a][b][m][n] = (f32x4){0.f, 0.f, 0.f, 0.f};
    bf16x8 At[4][2], B0[2][2], B1[2][2];
    const char* cA = (const char*)g.A + (size_t)cur.pm * tstep; const char* cB = (const char*)g.Bt + (size_t)cur.pn * tstep;
    S.a_ready(cur);
    PG8_STAGE(PG8_SB(0, 0), cB, voffB); PG8_STAGE(PG8_SA(0, 0), cA, voffA); PG8_STAGE(PG8_SB(0, 1), cB + hstep, voffB); PG8_STAGE(PG8_SA(0, 1), cA + hstep, voffA);
    if (wr == 1) PG8_BAR;
    PG8_WAIT_V(4); PG8_BAR;
    PG8_STAGE(PG8_SB(1, 0), cB + kstep, voffB); PG8_STAGE(PG8_SA(1, 0), cA + kstep, voffA); PG8_STAGE(PG8_SB(1, 1), cB + hstep + kstep, voffB);
    PG8_WAIT_V(6); PG8_BAR;
    for (;;) {
        const bool has_next = S.next(ui + 1, nxt);
        const char* nA = has_next ? (const char*)g.A + (size_t)nxt.pm * tstep : cA; const char* nB = has_next ? (const char*)g.Bt + (size_t)nxt.pn * tstep : cB;
        for (int t = 0; t < nt; t += 2) {
            const bool last = (t == nt - 2);
            const char* a1 = cA + (size_t)(t + 1) * kstep;
            const char* a2 = last ? nA : cA + (size_t)(t + 2) * kstep; const char* b2 = last ? nB : cB + (size_t)(t + 2) * kstep;
            const char* a3 = a2 + kstep; const char* b3 = b2 + kstep;
            if (last && has_next) S.a_ready(nxt);
            PG8_LDB(B0, 0, 0); PG8_SCHED; PG8_LDA(At, 0, 0); PG8_STAGE(PG8_SA(1, 1), a1 + hstep, voffA);
            PG8_WAIT_L(8); PG8_BAR; PG8_WAIT_L(0); PG8_MMA(0, 0, At, B0); PG8_BAR; PG8_SCHED;
            PG8_LDB(B1, 0, 1); PG8_STAGE(PG8_SB(0, 0), b2, voffB);
            PG8_BAR; PG8_WAIT_L(0); PG8_MMA(0, 1, At, B1); PG8_BAR;
            PG8_LDA(At, 0, 1); PG8_STAGE(PG8_SA(0, 0), a2, voffA);
            PG8_BAR; PG8_WAIT_L(0); PG8_MMA(1, 0, At, B0); PG8_BAR; PG8_SCHED;
            PG8_STAGE(PG8_SB(0, 1), b2 + hstep, voffB);
            PG8_WAIT_V(6); PG8_BAR; PG8_MMA(1, 1, At, B1); PG8_BAR;
            PG8_LDB(B0, 1, 0); PG8_SCHED; PG8_LDA(At, 1, 0); PG8_STAGE(PG8_SA(0, 1), a2 + hstep, voffA);
            PG8_WAIT_L(8); PG8_BAR; PG8_WAIT_L(0); PG8_MMA(0, 0, At, B0); PG8_BAR; PG8_SCHED;
            PG8_LDB(B1, 1, 1); PG8_STAGE(PG8_SB(1, 0), b3, voffB);
            PG8_BAR; PG8_WAIT_L(0); PG8_MMA(0, 1, At, B1); PG8_BAR;
            PG8_LDA(At, 1, 1); PG8_STAGE(PG8_SA(1, 0), a3, voffA);
            PG8_BAR; PG8_WAIT_L(0); PG8_MMA(1, 0, At, B0); PG8_BAR; PG8_SCHED;
            PG8_STAGE(PG8_SB(1, 1), b3 + hstep, voffB);
            PG8_WAIT_V(6); PG8_BAR; PG8_MMA(1, 1, At, B1); PG8_BAR;
        }
        if constexpr (!Epi::AFTER_DRAIN) { E(acc, cur, wr, wc, fr, fq); S.done(cur); }
        if (!has_next) break;
#pragma unroll
        for (int a = 0; a < 2; ++a)
#pragma unroll
            for (int b = 0; b < 2; ++b)
#pragma unroll
                for (int m = 0; m < 4; ++m)
#pragma unroll
                    for (int n = 0; n < 2; ++n) acc[a][b][m][n] = (f32x4){0.f, 0.f, 0.f, 0.f};
        cur = nxt; cA = nA; cB = nB; ++ui;
    }
    PG8_WAIT_V(0);
    if (wr == 0) PG8_BAR;
    PG8_BAR;
    if constexpr (Epi::AFTER_DRAIN) { E.fused(acc, cur, wr, wc, fr, fq, lds, wid, lane); S.done(cur); }
#undef PG8_SA
#undef PG8_SB
#undef PG8_STAGE
#undef PG8_LDA
#undef PG8_LDB
#undef PG8_MMA
#undef PG8_WAIT_V
#undef PG8_WAIT_L
#undef PG8_BAR
#undef PG8_SCHED
}
}

struct Ctx { int tid, bid, G; };
using pg8::bf16x8; using pg8::f32x4; using pg8::u32x4; using pg8::Unit; using pg8::cvt_pk_bf16;
constexpr int HALF = 128;
__device__ __forceinline__ float4 ldnt4(const float* q) { const f32x4 v = __builtin_nontemporal_load((const f32x4*)q); float4 r; r.x = v.x; r.y = v.y; r.z = v.z; r.w = v.w; return r; }

struct EpiStoreF32 {
  static constexpr bool PERM = false, AFTER_DRAIN = false;
  float* C; int ldc;
  __device__ __forceinline__ void operator()(const f32x4 (&acc)[2][2][4][2], const Unit& u, int wr, int wc, int fr, int fq) const {
    const int row0 = u.pm * 256 + wr * 64 + fr, col0 = u.pn * 256 + wc * 32 + 4 * fq;
#pragma unroll
    for (int ai = 0; ai < 2; ++ai)
#pragma unroll
      for (int m = 0; m < 4; ++m) { float* rowp = C + (size_t)(row0 + ai * HALF + m * 16) * ldc + col0;
#pragma unroll
        for (int bj = 0; bj < 2; ++bj)
#pragma unroll
          for (int n = 0; n < 2; ++n) *(f32x4*)(rowp + bj * HALF + n * 16) = acc[ai][bj][m][n]; }
  }
};
struct EpiRes {
  static constexpr bool PERM = false, AFTER_DRAIN = false;
  float* X;
  __device__ __forceinline__ void operator()(const f32x4 (&acc)[2][2][4][2], const Unit& u, int wr, int wc, int fr, int fq) const {
    const int row0 = u.pm * 256 + wr * 64 + fr, col0 = u.pn * 256 + wc * 32 + 4 * fq;
#pragma unroll
    for (int ai = 0; ai < 2; ++ai)
#pragma unroll
      for (int m = 0; m < 4; ++m) { float* rowp = X + (size_t)(row0 + ai * HALF + m * 16) * DM + col0;
        f32x4 o[2][2];
#pragma unroll
        for (int bj = 0; bj < 2; ++bj)
#pragma unroll
          for (int n = 0; n < 2; ++n) o[bj][n] = *(const f32x4*)(rowp + bj * HALF + n * 16);
#pragma unroll
        for (int bj = 0; bj < 2; ++bj)
#pragma unroll
          for (int n = 0; n < 2; ++n) *(f32x4*)(rowp + bj * HALF + n * 16) = o[bj][n] + acc[ai][bj][m][n];
        asm volatile("" ::: "memory"); }
  }
};
template <int ACT> struct EpiBf {
  static constexpr bool PERM = true, AFTER_DRAIN = false;
  bf16_t* O; int ldc;
  __device__ __forceinline__ void operator()(const f32x4 (&acc)[2][2][4][2], const Unit& u, int wr, int wc, int fr, int fq) const {
    const int row0 = u.pm * 256 + wr * 64 + fr, col0 = u.pn * 256 + wc * 32 + 8 * fq;
#pragma unroll
    for (int ai = 0; ai < 2; ++ai)
#pragma unroll
      for (int m = 0; m < 4; ++m) { bf16_t* rowp = O + (size_t)(row0 + ai * HALF + m * 16) * ldc + col0;
#pragma unroll
        for (int bj = 0; bj < 2; ++bj) { f32x4 v0 = acc[ai][bj][m][0], v1 = acc[ai][bj][m][1];
          if (ACT == 1) {
#pragma unroll
            for (int j = 0; j < 4; ++j) { const float a = fmaxf(v0[j], 0.f), b = fmaxf(v1[j], 0.f); v0[j] = a * a; v1[j] = b * b; } }
          u32x4 w; w.x = cvt_pk_bf16(v0[0], v0[1]); w.y = cvt_pk_bf16(v0[2], v0[3]); w.z = cvt_pk_bf16(v1[0], v1[1]); w.w = cvt_pk_bf16(v1[2], v1[3]);
          *(u32x4*)(rowp + bj * HALF) = w; } }
  }
};
struct EpiMemK {
  static constexpr bool PERM = false, AFTER_DRAIN = false;
  float* C; bf16_t* Kb;
  __device__ __forceinline__ void operator()(const f32x4 (&acc)[2][2][4][2], const Unit& u, int wr, int wc, int fr, int fq) const {
    const int rl0 = wr * 64 + fr, cl0 = wc * 32 + 4 * fq;
    bf16_t* kb = Kb + (size_t)(u.pm * 4 + u.pn) * 65536;
#pragma unroll
    for (int ai = 0; ai < 2; ++ai)
#pragma unroll
      for (int m = 0; m < 4; ++m) { const int rl = rl0 + ai * HALF + m * 16; float* rowp = C + (size_t)(u.pm * 256 + rl) * DM + u.pn * 256 + cl0;
#pragma unroll
        for (int bj = 0; bj < 2; ++bj)
#pragma unroll
          for (int n = 0; n < 2; ++n) { const f32x4 v = acc[ai][bj][m][n]; *(f32x4*)(rowp + bj * HALF + n * 16) = v;
            u32x2 w; w.x = cvt_pk_bf16(v[0], v[1]); w.y = cvt_pk_bf16(v[2], v[3]); *(u32x2*)(kb + rl * 256 + cl0 + bj * HALF + n * 16) = w; } }
  }
};
struct EpiVt {
  static constexpr bool PERM = true, AFTER_DRAIN = false;
  bf16_t* Vt;
  __device__ __forceinline__ void operator()(const f32x4 (&acc)[2][2][4][2], const Unit& u, int wr, int wc, int fr, int fq) const {
    bf16_t* vt = Vt + (size_t)(u.pn * 4 + u.pm) * 65536; const int rl0 = wr * 64 + fr, cl0 = wc * 32 + 8 * fq;
#pragma unroll
    for (int ai = 0; ai < 2; ++ai)
#pragma unroll
      for (int m = 0; m < 4; ++m) { bf16_t* rowp = vt + (rl0 + ai * HALF + m * 16) * 256 + cl0;
#pragma unroll
        for (int bj = 0; bj < 2; ++bj) { const f32x4 v0 = acc[ai][bj][m][0], v1 = acc[ai][bj][m][1];
          u32x4 w; w.x = cvt_pk_bf16(v0[0], v0[1]); w.y = cvt_pk_bf16(v0[2], v0[3]); w.z = cvt_pk_bf16(v1[0], v1[1]); w.w = cvt_pk_bf16(v1[2], v1[3]);
          *(u32x4*)(rowp + bj * HALF) = w; } }
  }
};
template <class Epi>
__device__ __forceinline__ void run_gemm(const Ctx cx0, LAS unsigned char* lds, const bf16_t* A, const bf16_t* Bt, int M, int N, int K, const Epi& E, int cid) {
  Ctx cx = cx0; asm volatile("" : "+v"(cx.tid));
  pg8::Gemm g{A, Bt, M, N, K, K}; pg8::StaticOrder S; S.init(M, N, cx.G, cid);
  pg8::gemm_phase<Epi, pg8::StaticOrder>(lds, g, S, E, cx.tid);
}
struct OneUnit {
  int pm, pn, valid;
  __device__ bool next(int i, Unit& u) const { if (i == 0 && valid) { u.pm = pm; u.pn = pn; return true; } return false; }
  __device__ __forceinline__ void a_ready(const Unit&) const {}
  __device__ __forceinline__ void done(const Unit&) const {}
};
struct EpiResAtomic {
  static constexpr bool PERM = false, AFTER_DRAIN = false;
  float* X;
  __device__ __forceinline__ void operator()(const f32x4 (&acc)[2][2][4][2], const Unit& u, int wr, int wc, int fr, int fq) const {
    const int row0 = u.pm * 256 + wr * 64 + fr, col0 = u.pn * 256 + wc * 32 + 4 * fq;
#pragma unroll
    for (int ai = 0; ai < 2; ++ai)
#pragma unroll
      for (int m = 0; m < 4; ++m) { float* rowp = X + (size_t)(row0 + ai * HALF + m * 16) * DM + col0;
#pragma unroll
        for (int bj = 0; bj < 2; ++bj)
#pragma unroll
          for (int n = 0; n < 2; ++n)
#pragma unroll
            for (int j = 0; j < 4; ++j) atomicAdd(rowp + bj * HALF + n * 16 + j, acc[ai][bj][m][n][j]); }
  }
};

template <bool FINAL, bool COPY>
__device__ void rms_rows(const Ctx cx, const float* srcA, const float* srcB, const float* gain, bf16_t* outb, float* outf, float* xres, const float* part, int npart) {
  const int lane = cx.tid & 63, gw = cx.bid * 8 + (cx.tid >> 6), nw = cx.G * 8;
  float4 g[4];
#pragma unroll
  for (int q = 0; q < 4; ++q) g[q] = *(const float4*)(gain + q * 256 + lane * 4);
  float4 nv[4];
  if (gw < T_ALL) { const float* s0_ = (gw < T_P) ? srcA + (size_t)gw * DM : srcB + (size_t)(gw - T_P) * DM;
#pragma unroll
    for (int q = 0; q < 4; ++q) nv[q] = *(const float4*)(s0_ + q * 256 + lane * 4); }
  for (int t = gw; t < T_ALL; t += nw) {
    const float* src = (t < T_P) ? srcA + (size_t)t * DM : srcB + (size_t)(t - T_P) * DM;
    float4 v[4]; float ss = 0.f;
#pragma unroll
    for (int q = 0; q < 4; ++q) v[q] = nv[q];
    { const int tn = t + nw; if (tn < T_ALL) { const float* sn_ = (tn < T_P) ? srcA + (size_t)tn * DM : srcB + (size_t)(tn - T_P) * DM;
#pragma unroll
        for (int q = 0; q < 4; ++q) nv[q] = *(const float4*)(sn_ + q * 256 + lane * 4); } }
    if (npart > 0 && t >= T_P) {
      for (int s_ = 0; s_ < npart; ++s_) { const float* pp = part + ((size_t)s_ * T_S + (t - T_P)) * DM;
#pragma unroll
        for (int q = 0; q < 4; ++q) { const float4 a = *(const float4*)(pp + q * 256 + lane * 4); v[q].x += a.x; v[q].y += a.y; v[q].z += a.z; v[q].w += a.w; } }
#pragma unroll
      for (int q = 0; q < 4; ++q) *(float4*)((float*)src + q * 256 + lane * 4) = v[q];
    }
#pragma unroll
    for (int q = 0; q < 4; ++q) { ss += v[q].x * v[q].x + v[q].y * v[q].y + v[q].z * v[q].z + v[q].w * v[q].w; }
    ss = wave_sum(ss, lane);
    const float r = rsqrtf(ss * (1.0f / 1024.0f) + 1e-6f);
#pragma unroll
    for (int q = 0; q < 4; ++q) {
      if (COPY) *(float4*)(xres + (size_t)t * DM + q * 256 + lane * 4) = v[q];
      const float a = v[q].x * r * g[q].x, b = v[q].y * r * g[q].y, c = v[q].z * r * g[q].z, d = v[q].w * r * g[q].w;
      if (FINAL) { float4 o; o.x = a; o.y = b; o.z = c; o.w = d; *(float4*)(outf + (size_t)t * DM + q * 256 + lane * 4) = o; }
      else { u32x2 w; w.x = pack2(a, b); w.y = pack2(c, d); *(u32x2*)(outb + (size_t)t * DM + q * 256 + lane * 4) = w; }
    }
  }
}

struct TDesc { const float* s0; const float* s1; bf16_t* dst; };
__device__ __forceinline__ TDesc tile_desc(KP p, int u, int tid) {
    const int l = u / 4192, r = u % 4192; int ldt = 0, koff = 0;
    bf16_t* wl = (bf16_t*)(p->ws + WS_WT + (size_t)l * WL_SIZE);
    const float* W; int K, N; bf16_t* Wt; int tt;
    if (r < 832) { W = p->in[I_WIN] + (size_t)l * DM * INW; K = DM; N = INW; Wt = (bf16_t*)((unsigned char*)wl + WL_IN); tt = r; }
    else if (r < 1088) { W = p->in[I_WOUT] + (size_t)l * DM * DM; K = DM; N = DM; Wt = (bf16_t*)((unsigned char*)wl + WL_OUT); tt = r - 832; }
    else if (r < 1344) { W = p->in[I_WQ] + (size_t)l * DM * DM; K = DM; N = DM; Wt = (bf16_t*)((unsigned char*)wl + WL_Q); tt = r - 1088; }
    else if (r < 1600) { W = p->in[I_WK] + (size_t)l * DM * DM; K = DM; N = DM; Wt = (bf16_t*)((unsigned char*)wl + WL_K); tt = r - 1344; }
    else if (r < 1856) { W = p->in[I_WV] + (size_t)l * DM * DM; K = DM; N = DM; Wt = (bf16_t*)((unsigned char*)wl + WL_V); tt = r - 1600; }
    else if (r < 2112) { W = p->in[I_WO] + (size_t)l * DM * DM; K = DM; N = DM; Wt = (bf16_t*)((unsigned char*)wl + WL_O); tt = r - 1856; }
    else if (r < 3136) { W = p->in[I_WUP] + (size_t)l * DM * DFF; K = DM; N = DFF; Wt = (bf16_t*)((unsigned char*)wl + WL_UP); tt = r - 2112; }
    else if (r < 4160) { W = p->in[I_WDOWN] + (size_t)l * DFF * DM; K = DFF; N = DM; Wt = (bf16_t*)((unsigned char*)wl + WL_DOWN); tt = r - 3136; }
    else if (r < 4176) { W = p->in[I_WGLU] + (size_t)l * 65536; K = 256; N = 256; Wt = (bf16_t*)((unsigned char*)wl + WL_GLU); tt = r - 4160; }
    else if (r < 4180) { W = p->in[I_RWW2] + (size_t)l * 64 * 256; K = 64; N = 256; Wt = (bf16_t*)(p->ws + WS_LORA) + (size_t)l * 65536; tt = r - 4176; ldt = 256; koff = 0; }
    else if (r < 4184) { W = p->in[I_RWA2] + (size_t)l * 64 * 256; K = 64; N = 256; Wt = (bf16_t*)(p->ws + WS_LORA) + (size_t)l * 65536; tt = r - 4180; ldt = 256; koff = 64; }
    else { W = p->in[I_RWG2] + (size_t)l * 128 * 256; K = 128; N = 256; Wt = (bf16_t*)(p->ws + WS_LORA) + (size_t)l * 65536; tt = r - 4184; ldt = 256; koff = 128; }
    if (ldt == 0) ldt = K;
    const int ntn = N / 64, tk = tt / ntn, tn = tt % ntn;
    TDesc d; d.s0 = W + (size_t)(tk * 64 + (tid >> 4)) * N + tn * 64 + (tid & 15) * 4; d.s1 = d.s0 + (size_t)32 * N;
    d.dst = Wt + (size_t)(tn * 64 + (tid >> 3)) * ldt + koff + tk * 64 + (tid & 7) * 8; return d;
}
__device__ void phase_prep(KP p, const Ctx cx, unsigned char* ldsraw) {
  const int tid = cx.tid;
  float* tl = (float*)ldsraw;
  { int u = cx.bid; TDesc d = tile_desc(p, u < 2 * 4192 ? u : 0, tid); float4 va = ldnt4(d.s0), vb = ldnt4(d.s1);
    for (; u < 2 * 4192; u += cx.G) {
      const int un = u + cx.G; const bool hn = un < 2 * 4192; TDesc dn = tile_desc(p, hn ? un : u, tid); float4 na = va, nb = vb;
      if (hn) { na = ldnt4(dn.s0); nb = ldnt4(dn.s1); }
      { const int k = tid >> 4, nc = (tid & 15) * 4;
        tl[k * 65 + nc] = va.x; tl[k * 65 + nc + 1] = va.y; tl[k * 65 + nc + 2] = va.z; tl[k * 65 + nc + 3] = va.w;
        tl[(k + 32) * 65 + nc] = vb.x; tl[(k + 32) * 65 + nc + 1] = vb.y; tl[(k + 32) * 65 + nc + 2] = vb.z; tl[(k + 32) * 65 + nc + 3] = vb.w; }
      __syncthreads();
      { const int n = tid >> 3, kc = (tid & 7) * 8; u32x4 w;
        w.x = pack2(tl[(kc + 0) * 65 + n], tl[(kc + 1) * 65 + n]); w.y = pack2(tl[(kc + 2) * 65 + n], tl[(kc + 3) * 65 + n]);
        w.z = pack2(tl[(kc + 4) * 65 + n], tl[(kc + 5) * 65 + n]); w.w = pack2(tl[(kc + 6) * 65 + n], tl[(kc + 7) * 65 + n]);
        *(u32x4*)d.dst = w; }
      __syncthreads();
      d = dn; va = na; vb = nb;
    }
  }
  const int gid = cx.bid * NTHR + tid, gsz = cx.G * NTHR;
  { const float* mem = p->in[I_MEM]; bf16_t* mb = (bf16_t*)(p->ws + WS_MEMB);
    for (int i = gid; i < 2048 * DM / 4; i += gsz) { const float4 v = *(const float4*)(mem + (size_t)i * 4); u32x2 w; w.x = pack2(v.x, v.y); w.y = pack2(v.z, v.w); *(u32x2*)(mb + (size_t)i * 4) = w; } }
  for (int i = gid; i < 2048; i += gsz) {
    const int l = (int)(i >> 10), gp = (int)(i & 1023), g = gp >> 6;
    float* cst = (float*)(p->ws + WS_S5C) + (size_t)l * 36864;
    const double lre = (double)p->in[I_LAMRE][l * 1024 + gp], lim = (double)p->in[I_LAMIM][l * 1024 + gp];
    const double step = exp((double)p->in[I_LOGSTEP][l * 16 + g]);
    double sn, cs; dsincos(lim * step, sn, cs);
    const double mag = exp(lre * step), bre_ = mag * cs, bim_ = mag * sn;
    cst[gp] = (float)bre_; cst[1024 + gp] = (float)bim_;
    double pr = bre_, pi = bim_;
#pragma unroll 1
    for (int q = 0; q < 6; ++q) { const double nr = pr * pr - pi * pi, ni = 2.0 * pr * pi; pr = nr; pi = ni; }
    cst[2048 + gp] = (float)pr; cst[3072 + gp] = (float)pi;
    const double nr_ = bre_ - 1.0, ni_ = bim_, den = lre * lre + lim * lim;
    const double fr_ = (nr_ * lre + ni_ * lim) / den, fi_ = (ni_ * lre - nr_ * lim) / den;
    for (int h = 0; h < 16; ++h) { const double br = (double)p->in[I_BRE][((size_t)l * 1024 + gp) * 16 + h], bi = (double)p->in[I_BIM][((size_t)l * 1024 + gp) * 16 + h];
      cst[4096 + gp * 16 + h] = (float)(fr_ * br - fi_ * bi); cst[4096 + 16384 + gp * 16 + h] = (float)(fr_ * bi + fi_ * br); }
  }
  for (int i = gid; i < 2056 * 32; i += gsz) {
    const int pi_ = (int)(i >> 5), j = (int)(i & 31);
    const float inv = (float)exp(-(double)j * (1.0 / 32.0) * 9.210340371976184);
    const float pos = (float)(pi_ < 2048 ? pi_ : 16384 + (pi_ - 2048));
    const float ang = pos * inv; double sn, cs; dsincos((double)ang, sn, cs);
    float* rp = (float*)(p->ws + WS_ROPE) + (size_t)pi_ * 64; rp[j] = (float)cs; rp[32 + j] = (float)sn;
  }
  rms_rows<false, true>(cx, p->in[I_XP], p->in[I_XS], p->in[I_NMIX], (bf16_t*)(p->ws + WS_HA), nullptr, (float*)(p->ws + WS_XRES), nullptr, 0);
}

__device__ __forceinline__ float tanh_(float x) { return 1.0f - 2.0f / (1.0f + __expf(2.0f * x)); }
__device__ void rwkv_prep(KP p, const Ctx cx, int l, unsigned char* ldsraw) {
  float* pm = (float*)ldsraw; bf16_t* actb = (bf16_t*)(ldsraw + 65536); float* part = (float*)(ldsraw + 65536 + 8448);
  const bf16_t* proj = (const bf16_t*)(p->ws + WS_PROJ); float* rec = (float*)(p->ws + WS_REC); float* gate = (float*)(p->ws + WS_GATE);
  const float* mu = p->in[I_RWMU] + l * 1024; const bf16_t* lw = (const bf16_t*)(p->ws + WS_LORA) + (size_t)l * 65536;
  const int tid = cx.tid, w = tid >> 6, lane = tid & 63, fr = lane & 15, kg = lane >> 4, head = w >> 1;
  bf16x8 bw[2][8]; float w0[2], a0[2], kkc[2], kac[2];
#pragma unroll
  for (int nt = 0; nt < 2; ++nt) { const int c = w * 32 + nt * 16 + fr;
#pragma unroll
    for (int ks = 0; ks < 8; ++ks) bw[nt][ks] = *(const bf16x8*)(lw + (size_t)c * 256 + ks * 32 + kg * 8);
    w0[nt] = p->in[I_RWW0][l * 256 + c]; a0[nt] = p->in[I_RWA0][l * 256 + c]; kkc[nt] = p->in[I_RWKK][l * 256 + c]; kac[nt] = p->in[I_RWKA][l * 256 + c]; }
  for (int tile = cx.bid; tile < T_ALL / 16; tile += cx.G) {
    const int t0 = tile * 16;
    {
      const int c4 = (tid & 255) * 4, g8 = (tid >> 8) * 8; const float4 m = *(const float4*)(mu + c4);
      float4 row[9];
#pragma unroll
      for (int k = 0; k < 8; ++k) row[k + 1] = ld4(proj + (size_t)(t0 + g8 + k) * INW + 2304 + c4);
      { const int t = t0 + g8; bool first; if (t < T_P) first = (t & 2047) == 0; else first = ((t - T_P) & 7) == 0;
        if (!first) row[0] = ld4(proj + (size_t)(t - 1) * INW + 2304 + c4);
        else if (t < T_P) { row[0].x = 0.f; row[0].y = 0.f; row[0].z = 0.f; row[0].w = 0.f; }
        else row[0] = *(const float4*)(p->in[I_SSHIFT] + ((size_t)l * 128 + ((t - T_P) >> 3)) * 1024 + c4); }
#pragma unroll
      for (int k = 0; k < 8; ++k) { const int i = g8 + k, t = t0 + i; const float4 cur = row[k + 1]; float4 prev = row[k];
        bool last; if (t < T_P) last = (t & 2047) == 2047; else last = ((t - T_P) & 7) == 7;
        float4 o; o.x = cur.x + (prev.x - cur.x) * m.x; o.y = cur.y + (prev.y - cur.y) * m.y; o.z = cur.z + (prev.z - cur.z) * m.z; o.w = cur.w + (prev.w - cur.w) * m.w;
        *(float4*)(pm + i * 1024 + c4) = o;
        if (c4 >= 768) { float4 a_; const int j = c4 - 768;
          if (j < 64) { a_.x = tanh_(o.x); a_.y = tanh_(o.y); a_.z = tanh_(o.z); a_.w = tanh_(o.w); } else if (j < 128) a_ = o; else { a_.x = sigm(o.x); a_.y = sigm(o.y); a_.z = sigm(o.z); a_.w = sigm(o.w); }
          u32x2 wv_; wv_.x = pack2(a_.x, a_.y); wv_.y = pack2(a_.z, a_.w); *(u32x2*)(actb + i * 264 + j) = wv_; }
        if (last) { float* dst = t < T_P ? p->out + O_PSH + ((size_t)l * 8 + (t >> 11)) * 1024 + c4 : p->out + O_SSH + ((size_t)l * 128 + ((t - T_P) >> 3)) * 1024 + c4; *(float4*)dst = cur; }
      }
    }
    __syncthreads();
    f32x4 accw[2], acca[2], accg[2];
#pragma unroll
    for (int nt = 0; nt < 2; ++nt) { accw[nt] = (f32x4){0.f, 0.f, 0.f, 0.f}; acca[nt] = accw[nt]; accg[nt] = accw[nt]; }
#pragma unroll
    for (int ks = 0; ks < 8; ++ks) { const bf16x8 a = *(const bf16x8*)(actb + fr * 264 + ks * 32 + kg * 8);
#pragma unroll
      for (int nt = 0; nt < 2; ++nt) {
        if (ks < 2) accw[nt] = __builtin_amdgcn_mfma_f32_16x16x32_bf16(a, bw[nt][ks], accw[nt], 0, 0, 0);
        else if (ks < 4) acca[nt] = __builtin_amdgcn_mfma_f32_16x16x32_bf16(a, bw[nt][ks], acca[nt], 0, 0, 0);
        else accg[nt] = __builtin_amdgcn_mfma_f32_16x16x32_bf16(a, bw[nt][ks], accg[nt], 0, 0, 0); } }
    float kv[4][2];
#pragma unroll
    for (int j = 0; j < 4; ++j) { const int tk = kg * 4 + j; float sq = 0.f;
#pragma unroll
      for (int nt = 0; nt < 2; ++nt) { const float k = pm[tk * 1024 + 256 + w * 32 + nt * 16 + fr]; kv[j][nt] = k; const float kkv = k * kkc[nt]; sq += kkv * kkv; }
      sq = row_sum16(sq); if (fr == 0) part[tk * 8 + w] = sq; }
    __syncthreads();
#pragma unroll
    for (int j = 0; j < 4; ++j) { const int tk = kg * 4 + j, t = t0 + tk;
      const float n2 = part[tk * 8 + (w & 6)] + part[tk * 8 + (w | 1)]; const float inv = 1.0f / fmaxf(sqrtf(n2), 1e-12f);
#pragma unroll
      for (int nt = 0; nt < 2; ++nt) { const int c = w * 32 + nt * 16 + fr, cc = c & 63;
        const float wv = w0[nt] + accw[nt][j]; const float decay = __expf(-0.6065306597126334f * sigm(wv)); const float iclr = sigm(a0[nt] + acca[nt][j]);
        const float k = kv[j][nt]; const float kkn = k * kkc[nt] * inv; const float k2 = k * (1.0f + (iclr - 1.0f) * kac[nt]);
        const float r = pm[tk * 1024 + c], v = pm[tk * 1024 + 512 + c];
        float* rp = rec + ((size_t)head * T_ALL + t) * 384 + cc;
        rp[0] = decay; rp[64] = kkn; rp[128] = kkn * iclr; rp[192] = k2; rp[256] = r; rp[320] = v;
        gate[(size_t)t * 256 + c] = accg[nt][j]; } }
    __syncthreads();
  }
}

__device__ __forceinline__ bf16x8 make_cf(const float* src, float sg) {
  const float4 a = *(const float4*)src, b = *(const float4*)(src + 4);
  u32x4 cw; cw.x = pack2(sg * a.x, sg * a.y); cw.y = pack2(sg * a.z, sg * a.w); cw.z = pack2(sg * b.x, sg * b.y); cw.w = pack2(sg * b.z, sg * b.w);
  bf16x8 r; __builtin_memcpy(&r, &cw, 16); return r;
}
template <bool FULL>
__device__ void s5_units(KP p, const Ctx cx, int l, unsigned char* ldsraw) {
  const int tid = cx.tid, w = tid >> 6, lane = tid & 63, fr = lane & 15, kg = lane >> 4;
  float* ubuf = (float*)(ldsraw + w * 8704);
  bf16_t* Ht = (bf16_t*)(ldsraw + w * 8704 + 4096);
  const float* cst = (const float*)(p->ws + WS_S5C) + (size_t)l * 36864;
  const bf16_t* proj = (const bf16_t*)(p->ws + WS_PROJ); float* E = (float*)(p->ws + WS_S5E);
  float* ysf = (float*)(p->ws + WS_YSF); bf16_t* ysb = (bf16_t*)(p->ws + WS_YSB);
  const int nunits = FULL ? 4096 + 2048 : 4096, gw = cx.bid * 8 + w, nw = cx.G * 8;
  for (int unit = gw; unit < nunits; unit += nw) {
    const bool sample = unit >= 4096;
    int seq, g, c, tok0, nsteps;
    if (!sample) { seq = unit >> 9; g = (unit >> 5) & 15; c = unit & 31; tok0 = seq * 2048 + c * 64; nsteps = 64; }
    else { const int u2 = unit - 4096; seq = u2 >> 4; g = u2 & 15; c = 0; tok0 = T_P + seq * 8; nsteps = 8; }
    for (int idx = lane; idx < nsteps * 4; idx += 64) { const int s = idx >> 2, q = idx & 3; *(float4*)(ubuf + s * 16 + q * 4) = ld4(proj + (size_t)(tok0 + s) * INW + g * 16 + q * 4); }
    const int gp = g * 64 + lane;
    float bre[16], bim[16];
#pragma unroll
    for (int q = 0; q < 4; ++q) { const float4 a = *(const float4*)(cst + 4096 + gp * 16 + q * 4), b = *(const float4*)(cst + 4096 + 16384 + gp * 16 + q * 4);
      bre[q * 4] = a.x; bre[q * 4 + 1] = a.y; bre[q * 4 + 2] = a.z; bre[q * 4 + 3] = a.w; bim[q * 4] = b.x; bim[q * 4 + 1] = b.y; bim[q * 4 + 2] = b.z; bim[q * 4 + 3] = b.w; }
    const float lre = cst[gp], lim = cst[1024 + gp];
    float hre = 0.f, him = 0.f;
    if (FULL) {
      if (sample) { hre = p->in[I_S5RE][((size_t)l * 128 + seq) * 1024 + gp]; him = p->in[I_S5IM][((size_t)l * 128 + seq) * 1024 + gp]; }
      else { const float qre = cst[2048 + gp], qim = cst[3072 + gp];
#pragma unroll 4
        for (int j = 0; j < c; ++j) { const float ere = E[((size_t)((seq * 16 + g) * 32 + j) * 2 + 0) * 64 + lane], eim = E[((size_t)((seq * 16 + g) * 32 + j) * 2 + 1) * 64 + lane];
          const float nr = qre * hre - qim * him + ere, ni = qre * him + qim * hre + eim; hre = nr; him = ni; } }
    }
    bf16x8 cf0 = {0, 0, 0, 0, 0, 0, 0, 0}, cf1 = cf0, cf2 = cf0, cf3 = cf0; float dsk = 0.f;
    if (FULL) {
      const float* cre = p->in[I_CRE] + ((size_t)(l * 16 + g) * 16 + fr) * 64 + kg * 8; const float* cim = p->in[I_CIM] + ((size_t)(l * 16 + g) * 16 + fr) * 64 + kg * 8;
      cf0 = make_cf(cre, 1.f); cf1 = make_cf(cre + 32, 1.f); cf2 = make_cf(cim, -1.f); cf3 = make_cf(cim + 32, -1.f);
      dsk = p->in[I_S5D][(l * 16 + g) * 16 + fr];
    }
    for (int tile = 0; tile * 16 < nsteps; ++tile) {
#pragma unroll 4
      for (int s = 0; s < 16; ++s) {
        const int st = tile * 16 + s;
        if (st < nsteps) {
          float br4[4], bi4[4];
#pragma unroll
          for (int q = 0; q < 4; ++q) { const float4 u = *(const float4*)(ubuf + st * 16 + q * 4);
            br4[q] = (bre[q * 4] * u.x + bre[q * 4 + 1] * u.y) + (bre[q * 4 + 2] * u.z + bre[q * 4 + 3] * u.w);
            bi4[q] = (bim[q * 4] * u.x + bim[q * 4 + 1] * u.y) + (bim[q * 4 + 2] * u.z + bim[q * 4 + 3] * u.w); }
          const float bur = (br4[0] + br4[1]) + (br4[2] + br4[3]), bui = (bi4[0] + bi4[1]) + (bi4[2] + bi4[3]);
          const float nr = lre * hre - lim * him + bur, ni = lre * him + lim * hre + bui; hre = nr; him = ni;
        }
        if (FULL) { Ht[s * 136 + lane] = f2bf(hre); Ht[s * 136 + 64 + lane] = f2bf(him); }
      }
      if (FULL) {
        f32x4 acc = {0.f, 0.f, 0.f, 0.f};
        { const bf16_t* hp = Ht + fr * 136 + kg * 8;
          acc = __builtin_amdgcn_mfma_f32_16x16x32_bf16(*(const bf16x8*)(hp), cf0, acc, 0, 0, 0); acc = __builtin_amdgcn_mfma_f32_16x16x32_bf16(*(const bf16x8*)(hp + 32), cf1, acc, 0, 0, 0);
          acc = __builtin_amdgcn_mfma_f32_16x16x32_bf16(*(const bf16x8*)(hp + 64), cf2, acc, 0, 0, 0); acc = __builtin_amdgcn_mfma_f32_16x16x32_bf16(*(const bf16x8*)(hp + 96), cf3, acc, 0, 0, 0); }
#pragma unroll
        for (int j = 0; j < 4; ++j) { const int tt = tile * 16 + kg * 4 + j;
          if (tt < nsteps) { const float uval = ubuf[tt * 16 + fr]; float y = acc[j] + dsk * uval;
            const float in = 0.7978845608028654f * (y + 0.044715f * y * y * y); y = 0.5f * y * (1.0f + tanh_(in));
            const size_t o = (size_t)(tok0 + tt) * 256 + g * 16 + fr; ysf[o] = y; ysb[o] = f2bf(y); } }
      }
    }
    if (!FULL) { E[((size_t)((seq * 16 + g) * 32 + c) * 2 + 0) * 64 + lane] = hre; E[((size_t)((seq * 16 + g) * 32 + c) * 2 + 1) * 64 + lane] = him; }
    else if (sample) { p->out[O_SRE + ((size_t)l * 128 + seq) * 1024 + gp] = hre; p->out[O_SIM + ((size_t)l * 128 + seq) * 1024 + gp] = him; }
    else if (c == 31) { p->out[O_PRE + ((size_t)l * 8 + seq) * 1024 + gp] = hre; p->out[O_PIM + ((size_t)l * 8 + seq) * 1024 + gp] = him; }
  }
}

constexpr int RW_STG = 6144, HB_BASE = 3 * 6144, HB_STG = 7168, OFF_HG = 0, OFF_RT = 4096;
#define DPPF(x, ctrl) __int_as_float(__builtin_amdgcn_update_dpp(0, __float_as_int(x), (ctrl), 0xf, 0xf, false))
__device__ __forceinline__ float sum8(float x) { x += DPPF(x, 0x141); x += DPPF(x, 0xB1); x += DPPF(x, 0x4E); return x; }
struct RwOp { f32x4 w, kk, ka, kv, rr; float vr; };
struct HgOp { f32x4 f0, f1, q0, q1; float vr; };
struct RtOp { f32x4 k0, k1, q0, q1; float vr; };
__device__ __forceinline__ void rw_load(RwOp& o, const float* buf, int i, int k4, int row) { const float* b = buf + i * 384;
  o.w = *(const f32x4*)(b + k4); o.kk = *(const f32x4*)(b + 64 + k4); o.ka = *(const f32x4*)(b + 128 + k4); o.kv = *(const f32x4*)(b + 192 + k4); o.rr = *(const f32x4*)(b + 256 + k4); o.vr = b[320 + row]; }
__device__ __forceinline__ float rw_step(const RwOp& o, f32x2& sA, f32x2& sB) {
  const f32x2 p = sA * o.kk.lo + sB * o.kk.hi;
  const float sa = -row_sum16(p.x + p.y);
  const f32x2 tA = o.kv.lo * o.vr + o.ka.lo * sa, tB = o.kv.hi * o.vr + o.ka.hi * sa;
  sA = sA * o.w.lo + tA; sB = sB * o.w.hi + tB;
  const f32x2 q = sA * o.rr.lo + sB * o.rr.hi;
  return row_sum16(q.x + q.y); }
__device__ __forceinline__ void hg_load(HgOp& o, const float* buf, int i, int k8, int row) { const float* b = buf + OFF_HG + i * 64;
  o.f0 = *(const f32x4*)(b + k8); o.f1 = *(const f32x4*)(b + k8 + 4); o.q0 = *(const f32x4*)(b + 2048 + k8); o.q1 = *(const f32x4*)(b + 2048 + k8 + 4); o.vr = b[3072 + row]; }
__device__ __forceinline__ float hg_step(const HgOp& o, f32x2 (&s)[4]) {
  const float v = o.vr;
  s[0] = (s[0] - v) * o.f0.lo + v; s[1] = (s[1] - v) * o.f0.hi + v; s[2] = (s[2] - v) * o.f1.lo + v; s[3] = (s[3] - v) * o.f1.hi + v;
  const f32x2 q = (s[0] * o.q0.lo + s[1] * o.q0.hi) + (s[2] * o.q1.lo + s[3] * o.q1.hi);
  return sum8(q.x + q.y); }
__device__ __forceinline__ void rt_load(RtOp& o, const float* buf, int i, int k8, int row) { const float* b = buf + OFF_RT + i * 64;
  o.k0 = *(const f32x4*)(b + k8); o.k1 = *(const f32x4*)(b + k8 + 4); o.q0 = *(const f32x4*)(b + 1024 + k8); o.q1 = *(const f32x4*)(b + 1024 + k8 + 4); o.vr = b[2048 + row]; }
__device__ __forceinline__ float rt_step(const RtOp& o, f32x2 (&s)[4], float gam) {
  const float v = o.vr;
  s[0] = s[0] * gam + o.k0.lo * v; s[1] = s[1] * gam + o.k0.hi * v; s[2] = s[2] * gam + o.k1.lo * v; s[3] = s[3] * gam + o.k1.hi * v;
  const f32x2 q = (s[0] * o.q0.lo + s[1] * o.q0.hi) + (s[2] * o.q1.lo + s[3] * o.q1.hi);
  return sum8(q.x + q.y); }

struct LdRegs { u32x2 hq, hf, hv, x1, x2, rv; float4 cs, sn; };
__device__ __forceinline__ void ld_dma(LAS unsigned char* gl, int wv, int nx, int bseq, int head, int lt, const float* rec) {
  const int tbn = nx < 128 ? bseq * 2048 + nx * 16 : T_P + (bseq * 16 + (nx - 128) * 2) * 8;
  const float* rb = rec + ((size_t)head * T_ALL + tbn) * 384 + wv * 256; LAS unsigned char* dst = gl + (nx % 3) * (6144 * 4) + wv * 1024; const unsigned lo = (unsigned)(lt & 63) * 4u;
#pragma unroll
  for (int n = 0; n < 6; ++n) __builtin_amdgcn_global_load_lds((const unsigned*)(rb + n * 1024 + lo), (LAS unsigned*)(dst + n * 4096), 16, 0, 0);
  asm volatile("" ::: "memory");
}
__device__ __forceinline__ void ld_loads(LdRegs& R, int nx, int bseq, int head, int hi, int hc4, int arr, int ri, int rc4, const bf16_t* proj, const float* rope) {
  const int tbn = nx < 128 ? bseq * 2048 + nx * 16 : T_P + (bseq * 16 + (nx - 128) * 2) * 8;
  const bf16_t* pb = proj + (size_t)tbn * INW + head * 64;
  const unsigned oh = (unsigned)(hi * INW + 256 + hc4), orr = (unsigned)(ri * INW + 1280 + arr * 256 + rc4);
  R.hq = *(const u32x2*)(pb + oh); R.hf = *(const u32x2*)(pb + oh + 256); R.hv = *(const u32x2*)(pb + oh + 512);
  R.x1 = *(const u32x2*)(pb + orr); R.x2 = *(const u32x2*)(pb + orr + 32);
  R.rv = *(const u32x2*)(pb + oh + 1536);
  const float* rpb = rope + (nx < 128 ? nx * 1024 : 2048 * 64); const unsigned orp = (unsigned)((nx < 128 ? ri : (ri & 7)) * 64 + rc4);
  R.cs = *(const float4*)(rpb + orp); R.sn = *(const float4*)(rpb + orp + 32);
  asm volatile("" ::: "memory");
}
__device__ __forceinline__ void ld_commit(const LdRegs& R, float* nb, int lt, int hi, int hc4, int arr, int ri, int rc4, const float4 lb) {
  const float4 Rhq = cv4(R.hq), Rhf = cv4(R.hf), Rhv = cv4(R.hv), Rx1 = cv4(R.x1), Rx2 = cv4(R.x2), Rrv = cv4(R.rv);
  { float4 o; o.x = siluf(Rhq.x); o.y = siluf(Rhq.y); o.z = siluf(Rhq.z); o.w = siluf(Rhq.w); *(float4*)(nb + OFF_HG + 2048 + hi * 64 + hc4) = o; *(float4*)(nb + OFF_HG + 3072 + hi * 64 + hc4) = Rhv;
    float4 f, ky;
    f.x = lb.x + (1.f - lb.x) * sigm(Rhf.x); ky.x = (1.f - lb.x) * sigm(-Rhf.x); f.y = lb.y + (1.f - lb.y) * sigm(Rhf.y); ky.y = (1.f - lb.y) * sigm(-Rhf.y);
    f.z = lb.z + (1.f - lb.z) * sigm(Rhf.z); ky.z = (1.f - lb.z) * sigm(-Rhf.z); f.w = lb.w + (1.f - lb.w) * sigm(Rhf.w); ky.w = (1.f - lb.w) * sigm(-Rhf.w);
    *(float4*)(nb + OFF_HG + hi * 64 + hc4) = f; *(float4*)(nb + OFF_HG + 1024 + hi * 64 + hc4) = ky; }
  { const float sc = arr == 1 ? 0.125f : 1.0f; float4 o1, o2; const float4 x1 = Rx1, x2 = Rx2, cs = R.cs, sn = R.sn;
    o1.x = (x1.x * cs.x - x2.x * sn.x) * sc; o2.x = (x1.x * sn.x + x2.x * cs.x) * sc; o1.y = (x1.y * cs.y - x2.y * sn.y) * sc; o2.y = (x1.y * sn.y + x2.y * cs.y) * sc;
    o1.z = (x1.z * cs.z - x2.z * sn.z) * sc; o2.z = (x1.z * sn.z + x2.z * cs.z) * sc; o1.w = (x1.w * cs.w - x2.w * sn.w) * sc; o2.w = (x1.w * sn.w + x2.w * cs.w) * sc;
    float* d = nb + OFF_RT + (arr == 1 ? 0 : 1024) + ri * 64 + rc4; *(float4*)d = o1; *(float4*)(d + 32) = o2;
    *(float4*)(nb + OFF_RT + 2048 + hi * 64 + hc4) = Rrv; }
}

__device__ void recur_phase(KP p, const Ctx cx, int l, float* lds, LAS unsigned char* gl) {
  const int tid = cx.tid, w = __builtin_amdgcn_readfirstlane(tid >> 6), lane = tid & 63, wv = w & 3;
  const bf16_t* proj = (const bf16_t*)(p->ws + WS_PROJ); const float* rec = (const float*)(p->ws + WS_REC); float* oraw = (float*)(p->ws + WS_ORAW);
  const float* lbl = p->in[I_LBLOG]; const float* rope = (const float*)(p->ws + WS_ROPE);
  for (int unit0 = cx.bid; unit0 < 256; unit0 += cx.G) {
    int unit = unit0; if (cx.G == 256) { const int xcd = unit0 & 7, j = unit0 >> 3; unit = (((j >> 3) * 8 + xcd) << 3) | (j & 7); }
    const int bseq = unit >> 5, head = (unit >> 3) & 3, rs = unit & 7;
    const float gam = 1.0f - exp2f(-5.0f - (float)head);
    const int rrow = rs * 8 + (w & 1) * 4 + (lane >> 4), k4 = (lane & 15) * 4;
    const int hrow = rs * 8 + (lane >> 3), k8 = (lane & 7) * 8;
    f32x2 sA = {0.f, 0.f}, sB = {0.f, 0.f};
    f32x2 s8[4];
#pragma unroll
    for (int j = 0; j < 4; ++j) s8[j] = (f32x2){0.f, 0.f};
    const float* st_in = w == 2 ? p->in[I_SHG] : p->in[I_SRT];
    float* st_ps = p->out + (w == 2 ? O_PHG : O_PRT); float* st_ss = p->out + (w == 2 ? O_SHG : O_SRT);
    const int lt = tid - 256, hi = (lt >> 4) & 15, hc4 = (lt & 15) * 4, arr = (lt >> 7) & 1, ri = (lt & 127) >> 3, rc4 = (lt & 7) * 4;
    float4 lb; lb.x = 0.f; lb.y = 0.f; lb.z = 0.f; lb.w = 0.f;
    if (l > 0 && w >= 4) { const float4 la = *(const float4*)(lbl + head * 64 + hc4), lc = *(const float4*)(lbl + 256 + head * 64 + hc4);
      lb.x = 1.0f / (1.0f + __expf(la.x - lc.x)); lb.y = 1.0f / (1.0f + __expf(la.y - lc.y)); lb.z = 1.0f / (1.0f + __expf(la.z - lc.z)); lb.w = 1.0f / (1.0f + __expf(la.w - lc.w)); }
    if (w >= 4) ld_dma(gl, wv, 0, bseq, head, lt, rec);
    for (int it = -1; it < 136; ++it) {
     {
      if (w >= 4) {
        if (it + 1 < 136) { LdRegs L; ld_loads(L, it + 1, bseq, head, hi, hc4, arr, ri, rc4, proj, rope);
#ifdef LOADER_TWICE
          asm volatile("s_waitcnt vmcnt(0)" ::: "memory"); { LdRegs L2; ld_loads(L2, (it + 9) % 128, bseq, head, hi, hc4, arr, ri, rc4, proj, rope); asm volatile("s_waitcnt vmcnt(0)" ::: "memory"); asm volatile("" :: "v"(L2.hq.x), "v"(L2.x1.x), "v"(L2.rv.x), "v"(L2.cs.x)); }
#endif
          ld_commit(L, lds + HB_BASE + ((it + 1) & 1) * HB_STG, lt, hi, hc4, arr, ri, rc4, lb);
          asm volatile("" ::: "memory");
          if (it + 2 < 136) ld_dma(gl, wv, it + 2, bseq, head, lt, rec); }
      } else if (it >= 0 && it < 136) {
        const float* buf = lds + (it % 3) * RW_STG; const float* hbuf = lds + HB_BASE + (it & 1) * HB_STG;
        const int tb = it < 128 ? bseq * 2048 + it * 16 : T_P + (bseq * 16 + (it - 128) * 2) * 8;
        if (w < 2) {
          float yk = 0.f;
          float4 nsA, nsB; nsA.x = nsA.y = nsA.z = nsA.w = 0.f; nsB = nsA;
          if (it >= 128) { const float* sp = p->in[I_SRW] + ((size_t)(l * 128 + bseq * 16 + (it - 128) * 2) * 4 + head) * 4096 + rrow * 64 + k4;
            nsA = *(const float4*)sp; nsB = *(const float4*)(sp + 4 * 4096); }
          {
            RwOp A, B, C;
#define RW_L(P, i) rw_load(P, buf, (i), k4, rrow); __builtin_amdgcn_sched_barrier(0)
#define RW_S(P, i) { const float y = rw_step(P, sA, sB); yk = ((lane & 15) == (i)) ? y : yk; } __builtin_amdgcn_sched_barrier(0)
            if (it >= 128) { sA = (f32x2){nsA.x, nsA.y}; sB = (f32x2){nsA.z, nsA.w}; }
            RW_L(A, 0); RW_L(B, 1); RW_L(C, 2);
            RW_S(A, 0); RW_L(A, 3); RW_S(B, 1); RW_L(B, 4); RW_S(C, 2); RW_L(C, 5);
            RW_S(A, 3); RW_L(A, 6); RW_S(B, 4); RW_L(B, 7); RW_S(C, 5); RW_L(C, 8);
            RW_S(A, 6); RW_L(A, 9); RW_S(B, 7); RW_L(B, 10);
            if (it >= 128) {
              float* dp = p->out + O_SRW + ((size_t)(l * 128 + bseq * 16 + (it - 128) * 2) * 4 + head) * 4096;
              float4 v; v.x = sA.x; v.y = sA.y; v.z = sB.x; v.w = sB.y; *(float4*)(dp + rrow * 64 + k4) = v;
              sA = (f32x2){nsB.x, nsB.y}; sB = (f32x2){nsB.z, nsB.w}; }
            RW_S(C, 8); RW_L(C, 11);
            RW_S(A, 9); RW_L(A, 12); RW_S(B, 10); RW_L(B, 13); RW_S(C, 11); RW_L(C, 14);
            RW_S(A, 12); RW_L(A, 15); RW_S(B, 13); RW_S(C, 14); RW_S(A, 15);
#undef RW_L
#undef RW_S
            if (it >= 127) { float* dp = it >= 128 ? p->out + O_SRW + ((size_t)(l * 128 + bseq * 16 + (it - 128) * 2 + 1) * 4 + head) * 4096 : p->out + O_PRW + ((size_t)(l * 8 + bseq) * 4 + head) * 4096;
              float4 v; v.x = sA.x; v.y = sA.y; v.z = sB.x; v.w = sB.y; *(float4*)(dp + rrow * 64 + k4) = v; }
          }
          { float* ob_ = oraw + (size_t)tb * 768 + 512 + head * 64; ob_[(unsigned)((lane & 15) * 768 + rrow)] = yk; }
        } else {
          float yk0 = 0.f, yk1 = 0.f;
          float nA[8], nB[8];
#pragma unroll
          for (int j = 0; j < 8; ++j) { nA[j] = 0.f; nB[j] = 0.f; }
          if (it >= 128) { const float* sp = st_in + ((size_t)(l * 128 + bseq * 16 + (it - 128) * 2) * 4 + head) * 4096;
#pragma unroll
            for (int j = 0; j < 8; ++j) { nA[j] = sp[(k8 + j) * 64 + hrow]; nB[j] = sp[4 * 4096 + (k8 + j) * 64 + hrow]; } }
          {
#define HS_SEL(i, y) { const bool m_ = (lane & 7) == ((i) & 7); if ((i) < 8) yk0 = m_ ? (y) : yk0; else yk1 = m_ ? (y) : yk1; }
#define MID_SWAP() if (it >= 128) { float* dp = st_ss + ((size_t)(l * 128 + bseq * 16 + (it - 128) * 2) * 4 + head) * 4096; \
              _Pragma("unroll") for (int j = 0; j < 4; ++j) { dp[(k8 + 2 * j) * 64 + hrow] = s8[j].x; dp[(k8 + 2 * j + 1) * 64 + hrow] = s8[j].y; s8[j] = (f32x2){nB[2 * j], nB[2 * j + 1]}; } }
            if (it >= 128) {
#pragma unroll
              for (int j = 0; j < 4; ++j) s8[j] = (f32x2){nA[2 * j], nA[2 * j + 1]}; }
            if (w == 2) {
              HgOp A, B, C;
#define H_L(P, i) hg_load(P, hbuf, (i), k8, hrow); __builtin_amdgcn_sched_barrier(0)
#define H_S(P, i) { const float y = hg_step(P, s8); HS_SEL(i, y) } __builtin_amdgcn_sched_barrier(0)
              H_L(A, 0); H_L(B, 1); H_L(C, 2);
              H_S(A, 0); H_L(A, 3); H_S(B, 1); H_L(B, 4); H_S(C, 2); H_L(C, 5);
              H_S(A, 3); H_L(A, 6); H_S(B, 4); H_L(B, 7); H_S(C, 5); H_L(C, 8);
              H_S(A, 6); H_L(A, 9); H_S(B, 7); H_L(B, 10);
              MID_SWAP()
              H_S(C, 8); H_L(C, 11);
              H_S(A, 9); H_L(A, 12); H_S(B, 10); H_L(B, 13); H_S(C, 11); H_L(C, 14);
              H_S(A, 12); H_L(A, 15); H_S(B, 13); H_S(C, 14); H_S(A, 15);
#undef H_L
#undef H_S
            } else {
              RtOp A, B, C;
#define H_L(P, i) rt_load(P, hbuf, (i), k8, hrow); __builtin_amdgcn_sched_barrier(0)
#define H_S(P, i) { const float y = rt_step(P, s8, gam); HS_SEL(i, y) } __builtin_amdgcn_sched_barrier(0)
              H_L(A, 0); H_L(B, 1); H_L(C, 2);
              H_S(A, 0); H_L(A, 3); H_S(B, 1); H_L(B, 4); H_S(C, 2); H_L(C, 5);
              H_S(A, 3); H_L(A, 6); H_S(B, 4); H_L(B, 7); H_S(C, 5); H_L(C, 8);
              H_S(A, 6); H_L(A, 9); H_S(B, 7); H_L(B, 10);
              MID_SWAP()
              H_S(C, 8); H_L(C, 11);
              H_S(A, 9); H_L(A, 12); H_S(B, 10); H_L(B, 13); H_S(C, 11); H_L(C, 14);
              H_S(A, 12); H_L(A, 15); H_S(B, 13); H_S(C, 14); H_S(A, 15);
#undef H_L
#undef H_S
            }
#undef HS_SEL
#undef MID_SWAP
            if (it >= 127) { float* dp = it >= 128 ? st_ss + ((size_t)(l * 128 + bseq * 16 + (it - 128) * 2 + 1) * 4 + head) * 4096 : st_ps + ((size_t)(l * 8 + bseq) * 4 + head) * 4096;
#pragma unroll
              for (int j = 0; j < 4; ++j) { dp[(k8 + 2 * j) * 64 + hrow] = s8[j].x; dp[(k8 + 2 * j + 1) * 64 + hrow] = s8[j].y; } }
          }
          { float* ob_ = oraw + (size_t)tb * 768 + (w == 2 ? 0 : 256) + head * 64; const unsigned oo = (unsigned)((lane & 7) * 768 + hrow); ob_[oo] = yk0; ob_[oo + 8 * 768] = yk1; }
        }
      }
      asm volatile("s_waitcnt lgkmcnt(0)" ::: "memory"); __builtin_amdgcn_s_barrier(); asm volatile("" ::: "memory");
     }
    }
    __syncthreads();
  }
}

__device__ void mix_phase(KP p, const Ctx cx, int l) {
  const int lane = cx.tid & 63, gw = cx.bid * 8 + (cx.tid >> 6), nw = cx.G * 8, c = lane * 4, head = lane >> 4, cc = (lane & 15) * 4;
  const bf16_t* proj = (const bf16_t*)(p->ws + WS_PROJ); const float* rec = (const float*)(p->ws + WS_REC); const float* gate = (const float*)(p->ws + WS_GATE);
  const float* oraw = (const float*)(p->ws + WS_ORAW); const float* gluo = (const float*)(p->ws + WS_GLUO); bf16_t* mix = (bf16_t*)(p->ws + WS_MIX);
  const float* ysf = (const float*)(p->ws + WS_YSF); const float4 bgl = *(const float4*)(p->in[I_BGLU] + l * 256 + c);
  const float4 s5n = *(const float4*)(p->in[I_S5NORM] + l * 256 + c), hgn = *(const float4*)(p->in[I_HGNORM] + l * 256 + c);
  const float4 lng = *(const float4*)(p->in[I_RWLNG] + l * 256 + c), lnb = *(const float4*)(p->in[I_RWLNB] + l * 256 + c), rk = *(const float4*)(p->in[I_RWRK] + l * 256 + c);
  struct MixIn { float4 z, yv, oh, gph, ort, gpr, y, k2, rr, v, gt; };
#define MIX_LOAD(M, t_) { const int tt_ = (t_); M.z = ldnt4(gluo + (size_t)tt_ * 256 + c); M.yv = ldnt4(ysf + (size_t)tt_ * 256 + c); \
    M.oh = ldnt4(oraw + (size_t)tt_ * 768 + c); M.gph = ld4(proj + (size_t)tt_ * INW + 256 + 768 + c); \
    M.ort = ldnt4(oraw + (size_t)tt_ * 768 + 256 + c); M.gpr = ld4(proj + (size_t)tt_ * INW + 1280 + 768 + c); \
    M.y = ldnt4(oraw + (size_t)tt_ * 768 + 512 + c); const float* rp_ = rec + ((size_t)head * T_ALL + tt_) * 384 + cc; \
    M.k2 = ldnt4(rp_ + 192); M.rr = ldnt4(rp_ + 256); M.v = ldnt4(rp_ + 320); M.gt = ldnt4(gate + (size_t)tt_ * 256 + c); }
  MixIn cur; if (gw < T_ALL) MIX_LOAD(cur, gw)
  for (int t = gw; t < T_ALL; t += nw) {
    MixIn nxt = cur; const int tn = t + nw; if (tn < T_ALL) MIX_LOAD(nxt, tn)
    bf16_t* mrow = mix + (size_t)t * DM;
    const float4 z = cur.z, yv = cur.yv, oh = cur.oh, gph = cur.gph, ort = cur.ort, gpr = cur.gpr, y = cur.y, k2 = cur.k2, rr = cur.rr, v = cur.v, gt = cur.gt;
    { float4 g; g.x = yv.x * sigm(z.x + bgl.x); g.y = yv.y * sigm(z.y + bgl.y); g.z = yv.z * sigm(z.z + bgl.z); g.w = yv.w * sigm(z.w + bgl.w);
      const float ss = wave_sum(g.x * g.x + g.y * g.y + g.z * g.z + g.w * g.w, lane);
      const float r = rsqrtf(ss * (1.0f / 256.0f) + 1e-6f); u32x2 w; w.x = pack2(g.x * r * s5n.x, g.y * r * s5n.y); w.y = pack2(g.z * r * s5n.z, g.w * r * s5n.w); *(u32x2*)(mrow + c) = w; }
    { const float4 o = oh; const float hs = row_sum16(o.x * o.x + o.y * o.y + o.z * o.z + o.w * o.w);
      const float r = rsqrtf(hs * (1.0f / 64.0f) + 1e-6f); const float4 gp = gph;
      u32x2 w; w.x = pack2(o.x * r * hgn.x * siluf(gp.x), o.y * r * hgn.y * siluf(gp.y)); w.y = pack2(o.z * r * hgn.z * siluf(gp.z), o.w * r * hgn.w * siluf(gp.w)); *(u32x2*)(mrow + 256 + c) = w; }
    { const float4 o = ort; const float hs = row_sum16(o.x * o.x + o.y * o.y + o.z * o.z + o.w * o.w);
      const float r = rsqrtf(hs * (1.0f / 64.0f) + 1e-6f); const float4 gp = gpr;
      u32x2 w; w.x = pack2(o.x * r * siluf(gp.x), o.y * r * siluf(gp.y)); w.y = pack2(o.z * r * siluf(gp.z), o.w * r * siluf(gp.w)); *(u32x2*)(mrow + 512 + c) = w; }
    { const float mean = row_sum16(y.x + y.y + y.z + y.w) * (1.0f / 64.0f);
      const float dx = y.x - mean, dy = y.y - mean, dz = y.z - mean, dw = y.w - mean; const float var = row_sum16(dx * dx + dy * dy + dz * dz + dw * dw) * (1.0f / 64.0f);
      const float r = rsqrtf(var + 64e-5f);
      const float bonus = row_sum16(rr.x * k2.x * rk.x + rr.y * k2.y * rk.y + rr.z * k2.z * rk.z + rr.w * k2.w * rk.w);
      const float4 g = gt;
      u32x2 w; w.x = pack2((dx * r * lng.x + lnb.x + bonus * v.x) * g.x, (dy * r * lng.y + lnb.y + bonus * v.y) * g.y);
      w.y = pack2((dz * r * lng.z + lnb.z + bonus * v.z) * g.z, (dw * r * lng.w + lnb.w + bonus * v.w) * g.w); *(u32x2*)(mrow + 768 + c) = w; }
    cur = nxt;
  }
#undef MIX_LOAD
}

constexpr int KV_LD = 264;
__device__ __forceinline__ void load_kv_tile(const Ctx cx, const bf16_t* src, bf16_t* dst) {
  const int tid = cx.tid;
  u32x4 tv[16];
#pragma unroll
  for (int n = 0; n < 16; ++n) { const int idx = tid + n * 512, r = idx >> 5, c = (idx & 31) * 8; tv[n] = *(const u32x4*)(src + r * 256 + c); }
#pragma unroll
  for (int n = 0; n < 16; ++n) { const int idx = tid + n * 512, r = idx >> 5, c = (idx & 31) * 8; *(u32x4*)(dst + r * KV_LD + c) = tv[n]; }
}
__device__ void attn_prompt_unit(KP p, const Ctx cx, int l, int unit, unsigned char* ldsraw) {
  const int tid = cx.tid, w = tid >> 6, lane = tid & 63, fr = lane & 15, kg = lane >> 4;
  const int b = unit >> 6, head = (unit >> 4) & 3, qt = unit & 15;
  bf16_t* kv = (bf16_t*)ldsraw;
  const bf16_t* Kb = (const bf16_t*)(p->ws + WS_KB) + ((size_t)l * 32 + b * 4 + head) * 65536;
  const bf16_t* Vt = (const bf16_t*)(p->ws + WS_VT) + ((size_t)l * 32 + b * 4 + head) * 65536;
  const bf16_t* qb = (const bf16_t*)(p->ws + WS_QB); bf16_t* ob = (bf16_t*)(p->ws + WS_OB);
  const int tq = b * 2048 + qt * 128 + w * 16 + fr;
  load_kv_tile(cx, Kb, kv);
  bf16x8 qf[8];
#pragma unroll
  for (int ks = 0; ks < 8; ++ks) qf[ks] = *(const bf16x8*)(qb + (size_t)tq * DM + head * 256 + ks * 32 + kg * 8);
  __syncthreads();
  f32x4 sacc[16];
#pragma unroll
  for (int nt = 0; nt < 16; ++nt) { f32x4 a = {0.f, 0.f, 0.f, 0.f};
#pragma unroll
    for (int ks = 0; ks < 8; ++ks) { const bf16x8 kf = *(const bf16x8*)(kv + (nt * 16 + fr) * KV_LD + ks * 32 + kg * 8); a = __builtin_amdgcn_mfma_f32_16x16x32_bf16(kf, qf[ks], a, 0, 0, 0); }
    sacc[nt] = a; }
  float mx = -3.0e38f;
#pragma unroll
  for (int nt = 0; nt < 16; ++nt) mx = fmaxf(mx, fmaxf(fmaxf(sacc[nt][0], sacc[nt][1]), fmaxf(sacc[nt][2], sacc[nt][3])));
  mx = fmaxf(mx, shx(mx, 16, lane)); mx = fmaxf(mx, shx(mx, 32, lane));
  float sum = 0.f; bf16x8 pf[8];
#pragma unroll
  for (int k2 = 0; k2 < 8; ++k2) {
    float e[8];
#pragma unroll
    for (int j = 0; j < 4; ++j) { e[j] = __expf((sacc[2 * k2][j] - mx) * 0.0625f); e[4 + j] = __expf((sacc[2 * k2 + 1][j] - mx) * 0.0625f); }
#pragma unroll
    for (int j = 0; j < 8; ++j) { sum += e[j]; pf[k2][j] = (short)f2bf(e[j]); }
  }
  sum += shx(sum, 16, lane); sum += shx(sum, 32, lane);
  const float inv = 1.0f / sum;
  __syncthreads();
  load_kv_tile(cx, Vt, kv);
  __syncthreads();
#pragma unroll 1
  for (int dt = 0; dt < 16; ++dt) { f32x4 a = {0.f, 0.f, 0.f, 0.f};
#pragma unroll
    for (int k2 = 0; k2 < 8; ++k2) { const bf16_t* vp = kv + (dt * 16 + fr) * KV_LD + k2 * 32 + kg * 4;
      const u32x2 lo = *(const u32x2*)vp, hi = *(const u32x2*)(vp + 16); u32x4 vv; vv.x = lo.x; vv.y = lo.y; vv.z = hi.x; vv.w = hi.y;
      bf16x8 vf; __builtin_memcpy(&vf, &vv, 16);
      a = __builtin_amdgcn_mfma_f32_16x16x32_bf16(vf, pf[k2], a, 0, 0, 0); }
    u32x2 wv; wv.x = pack2(a[0] * inv, a[1] * inv); wv.y = pack2(a[2] * inv, a[3] * inv);
    *(u32x2*)(ob + (size_t)tq * DM + head * 256 + dt * 16 + kg * 4) = wv; }
  __syncthreads();
}

__device__ void attn_sample_unit(KP p, const Ctx cx, int l, int unit, unsigned char* ldsraw) {
  const int tid = cx.tid, w = tid >> 6, lane = tid & 63;
  const int b = unit >> 2, head = unit & 3;
  float* qs = (float*)ldsraw;
  float* S = qs + 2048;
  float* Pt = S + 2048;
  float* red = Pt + 2048;
  const bf16_t* qb = (const bf16_t*)(p->ws + WS_QB); bf16_t* ob = (bf16_t*)(p->ws + WS_OB);
  const float* Kc = p->in[I_CK] + ((size_t)(l * 128 + b) * 256) * 1024 + head * 256;
  const float* Vc = p->in[I_CV] + ((size_t)(l * 128 + b) * 256) * 1024 + head * 256;
  const int t0 = T_P + b * 8;
  { const float* qp = (const float*)(p->ws + WS_PART) + (size_t)(b * 8) * DM + head * 256;
    for (int idx = tid; idx < 2048; idx += NTHR) { const size_t o = (size_t)(idx >> 8) * DM + (idx & 255);
      qs[idx] = (qp[o] + qp[o + (size_t)T_S * DM]) + (qp[o + (size_t)2 * T_S * DM] + qp[o + (size_t)3 * T_S * DM]); } }
  __syncthreads();
  float4 q[8];
#pragma unroll
  for (int i = 0; i < 8; ++i) q[i] = *(const float4*)(qs + i * 256 + lane * 4);
#pragma unroll 1
  for (int kb2 = 0; kb2 < 2; ++kb2) {
   f32x4 kx[16];
#pragma unroll
   for (int kk = 0; kk < 16; ++kk) kx[kk] = __builtin_nontemporal_load((const f32x4*)(Kc + (size_t)(w * 32 + kb2 * 16 + kk) * 1024 + lane * 4));
#pragma unroll
   for (int kh = 0; kh < 2; ++kh) {
    const int kb = kb2 * 2 + kh;
    float v[64];
#pragma unroll
    for (int kk = 0; kk < 8; ++kk) {
#pragma unroll
      for (int i = 0; i < 8; ++i) v[kk * 8 + i] = kx[kh * 8 + kk].x * q[i].x + kx[kh * 8 + kk].y * q[i].y + kx[kh * 8 + kk].z * q[i].z + kx[kh * 8 + kk].w * q[i].w; }
#pragma unroll
    for (int off = 32; off >= 1; off >>= 1) { const bool up = (lane & off) != 0;
#pragma unroll
      for (int i = 0; i < off; ++i) { const float send = up ? v[i] : v[i + off]; const float keep = up ? v[i + off] : v[i]; v[i] = keep + shx(send, off, lane); } }
    S[(lane & 7) * 256 + w * 32 + kb * 8 + (lane >> 3)] = v[0];
   }
  }
  __syncthreads();
  { const float4 s = *(const float4*)(S + w * 256 + lane * 4); const float mx = wave_max(fmaxf(fmaxf(s.x, s.y), fmaxf(s.z, s.w)), lane);
    const float e0 = __expf((s.x - mx) * 0.0625f), e1 = __expf((s.y - mx) * 0.0625f), e2 = __expf((s.z - mx) * 0.0625f), e3 = __expf((s.w - mx) * 0.0625f);
    const float inv = 1.0f / wave_sum(e0 + e1 + e2 + e3, lane);
    Pt[(lane * 4 + 0) * 8 + w] = e0 * inv; Pt[(lane * 4 + 1) * 8 + w] = e1 * inv; Pt[(lane * 4 + 2) * 8 + w] = e2 * inv; Pt[(lane * 4 + 3) * 8 + w] = e3 * inv; }
  __syncthreads();
  float4 acc[8];
#pragma unroll
  for (int i = 0; i < 8; ++i) { acc[i].x = 0.f; acc[i].y = 0.f; acc[i].z = 0.f; acc[i].w = 0.f; }
#pragma unroll 16
  for (int kk = 0; kk < 32; ++kk) { const int m = w * 32 + kk; const f32x4 vx = __builtin_nontemporal_load((const f32x4*)(Vc + (size_t)m * 1024 + lane * 4));
    const float4 p0 = *(const float4*)(Pt + m * 8), p1 = *(const float4*)(Pt + m * 8 + 4); const float pr[8] = {p0.x, p0.y, p0.z, p0.w, p1.x, p1.y, p1.z, p1.w};
#pragma unroll
    for (int i = 0; i < 8; ++i) { acc[i].x += pr[i] * vx.x; acc[i].y += pr[i] * vx.y; acc[i].z += pr[i] * vx.z; acc[i].w += pr[i] * vx.w; } }
#pragma unroll
  for (int i = 0; i < 8; ++i) *(float4*)(red + (w * 8 + i) * 256 + lane * 4) = acc[i];
  __syncthreads();
  { const int i = tid >> 6; float4 s; s.x = 0.f; s.y = 0.f; s.z = 0.f; s.w = 0.f;
#pragma unroll
    for (int ww = 0; ww < 8; ++ww) { const float4 r = *(const float4*)(red + (ww * 8 + i) * 256 + lane * 4); s.x += r.x; s.y += r.y; s.z += r.z; s.w += r.w; }
    u32x2 o; o.x = pack2(s.x, s.y); o.y = pack2(s.z, s.w); *(u32x2*)(ob + (size_t)(t0 + i) * DM + head * 256 + lane * 4) = o; }
  __syncthreads();
}


#define XB_TMO      128
#define XB_XCNT(j)  (256  + 64 * (j))
#define XB_XSUB(j)  (1280 + 64 * (j))
#define XB_XGEN(j)  (2304 + 64 * (j))
#define XB_TOP      3328
#define XB_TOPGEN   3392
#define XCD_BAR_WORDS 3456
#define XB_SPIN_CAP (1u << 18)

__device__ __forceinline__ unsigned xb_ld(unsigned* p)              { return __hip_atomic_load(p, __ATOMIC_RELAXED, __HIP_MEMORY_SCOPE_AGENT); }
__device__ __forceinline__ unsigned xb_add(unsigned* p, unsigned v) { return __hip_atomic_fetch_add(p, v, __ATOMIC_RELAXED, __HIP_MEMORY_SCOPE_AGENT); }
__device__ __forceinline__ unsigned xb_xcc_id() { return (unsigned)__builtin_amdgcn_s_getreg((3 << 11) | 20) & 0xFu; }
#define XB_SPIN(cond, bar) do { unsigned _sp = 0; while (cond) { __builtin_amdgcn_s_sleep(1); \
    if ((++_sp & 255u) == 0u) { if (xb_ld(&(bar)[XB_TMO])) break; if (_sp > XB_SPIN_CAP) { atomicAdd(&(bar)[XB_TMO], 1u); break; } } } } while (0)
struct XcdBarrier {
    unsigned* bar; unsigned x;
    volatile LAS unsigned* st;
};

__device__ __forceinline__ XcdBarrier xcd_barrier_post(unsigned* bar, volatile LAS unsigned* st, int tid) {
    XcdBarrier b; b.bar = bar; b.x = xb_xcc_id(); b.st = st;
    if (tid == 0) (void)xb_add(&bar[XB_XCNT(b.x)], 1u);
    return b;
}
__device__ __forceinline__ void xcd_barrier_complete(unsigned* bar, unsigned x, unsigned& nloc, unsigned& nx) {
    const unsigned G = gridDim.x * gridDim.y * gridDim.z;
    unsigned sum, cnt, mine, sp = 0u;
    for (;;) {
        sum = 0u; cnt = 0u; mine = 0u;
#pragma unroll
        for (unsigned j = 0; j < 16; ++j) { const unsigned c = xb_ld(&bar[XB_XCNT(j)]); sum += c; cnt += (c > 0u) ? 1u : 0u; mine = (j == x) ? c : mine; }
        if (sum == G) break;
        __builtin_amdgcn_s_sleep(1);
        if ((++sp & 255u) == 0u) { if (xb_ld(&bar[XB_TMO])) break; if (sp > XB_SPIN_CAP) { atomicAdd(&bar[XB_TMO], 1u); break; } }
    }
    nloc = mine > 0u ? mine : 1u; nx = cnt > 0u ? cnt : 1u;
}

__device__ __forceinline__ void xcd_barrier(const XcdBarrier& b, int tid) {
    asm volatile("s_waitcnt vmcnt(0)" ::: "memory");
    __syncthreads();
    if (tid == 0) {
        unsigned* bar = b.bar;
        __builtin_amdgcn_s_waitcnt(0);
        unsigned nloc = b.st[0], nx = b.st[1];
        if (nloc == 0u) { xcd_barrier_complete(bar, b.x, nloc, nx); b.st[0] = nloc; b.st[1] = nx; }
        const unsigned old = xb_add(&bar[XB_XSUB(b.x)], 1u);
        const unsigned gen = old / nloc;
        if (old + 1u == (gen + 1u) * nloc) {
            __builtin_amdgcn_fence(__ATOMIC_RELEASE, "agent");
            asm volatile("s_waitcnt vmcnt(0)" ::: "memory");
            const unsigned og = xb_add(&bar[XB_TOP], 1u);
            const unsigned tg = og / nx;
            if (og + 1u == (tg + 1u) * nx) xb_add(&bar[XB_TOPGEN], 1u);
            else XB_SPIN(xb_ld(&bar[XB_TOPGEN]) == tg, bar);
            __builtin_amdgcn_fence(__ATOMIC_ACQUIRE, "agent");
            xb_add(&bar[XB_XGEN(b.x)], 1u);
            asm volatile("s_waitcnt vmcnt(0)" ::: "memory");
        } else {
            XB_SPIN(xb_ld(&bar[XB_XGEN(b.x)]) == gen, bar);
            __builtin_amdgcn_fence(__ATOMIC_ACQUIRE, "agent");
            asm volatile("s_waitcnt vmcnt(0)" ::: "memory");
        }
    }
    __syncthreads();
}


#ifndef REPEAT_S
#define REPEAT_S -1
#endif
constexpr int NPHASE = REPEAT_S >= 0 ? 31 : 29;
__global__ void __launch_bounds__(512) mega(Params p_) {
  extern __shared__ __attribute__((aligned(16))) unsigned char lds[];
  cg::grid_group grid = cg::this_grid();
  LAS unsigned char* gl = (LAS unsigned char*)lds;
  const int ph_lo = p_.ph_lo, ph_hi = p_.ph_hi;
  const int wid0 = __builtin_amdgcn_readfirstlane((int)threadIdx.x >> 6);
#ifndef PH_MASK
#define PH_MASK 0xFFFF
#endif
#define PHON(x) ((PH_MASK >> (x)) & 1)
#define MK_CTX() Ctx cx; { int ln_; asm volatile("v_mbcnt_lo_u32_b32 %0, -1, 0\n\tv_mbcnt_hi_u32_b32 %0, -1, %0" : "=v"(ln_)); cx.tid = wid0 * 64 + ln_; } cx.bid = blockIdx.x; cx.G = gridDim.x; asm volatile("" : "+s"(cx.bid), "+s"(cx.G));
  volatile LAS unsigned* xst = (volatile LAS unsigned*)(gl + LDS_MAIN);
  if (threadIdx.x == 0) { xst[0] = 0u; xst[1] = 0u; }
  __syncthreads();
  XcdBarrier xb = xcd_barrier_post((unsigned*)(p_.ws + WS_BAR), xst, (int)threadIdx.x);
  int ph = ph_lo;
  if (ph == 0) {
    KP p = get_params(); MK_CTX();
    if (PHON(14)) phase_prep(p, cx, lds);
    ph = 1; if (ph < ph_hi) grid.sync();
  }
  for (; ph < ph_hi; ++ph) {
    KP p = get_params(); MK_CTX();
#ifndef REPEAT_S
#define REPEAT_S -1
#endif
#ifndef EXTRA_SYNC
#define EXTRA_SYNC 0
#endif
    {
#if REPEAT_S >= 0
      const int l = (ph - 1) / 15, k_ = (ph - 1) % 15, s = k_ <= REPEAT_S ? k_ : k_ - 1;
#else
      const int l = (ph - 1) / 14, s = (ph - 1) % 14;
#endif
      unsigned char* wl = p->ws + WS_WT + (size_t)l * WL_SIZE;
      bf16_t* hA = (bf16_t*)(p->ws + WS_HA); float* xres = (float*)(p->ws + WS_XRES);
      if (s == 0 && PHON(0)) {
        { EpiBf<0> E{(bf16_t*)(p->ws + WS_PROJ), INW}; run_gemm(cx, gl, hA, (const bf16_t*)(wl + WL_IN), T_ALL, INW, DM, E, cx.bid); }
        const bf16_t* memb = (const bf16_t*)(p->ws + WS_MEMB);
        { EpiMemK E{p->out + O_PMK + (size_t)l * 2097152, (bf16_t*)(p->ws + WS_KB) + (size_t)l * 32 * 65536}; run_gemm(cx, gl, memb, (const bf16_t*)(wl + WL_K), 2048, DM, DM, E, (cx.bid + cx.G - 128 % cx.G) % cx.G); }
        { EpiStoreF32 E{p->out + O_PMV + (size_t)l * 2097152, DM}; run_gemm(cx, gl, memb, (const bf16_t*)(wl + WL_V), 2048, DM, DM, E, (cx.bid + cx.G - 160 % cx.G) % cx.G); }
        { EpiVt E{(bf16_t*)(p->ws + WS_VT) + (size_t)l * 32 * 65536}; run_gemm(cx, gl, (const bf16_t*)(wl + WL_V), memb, DM, 2048, DM, E, (cx.bid + cx.G - 192 % cx.G) % cx.G); }
      } else if (s == 1 && PHON(1)) {
        rwkv_prep(p, cx, l, lds);
        s5_units<false>(p, cx, l, lds);
      } else if (s == 2 && PHON(2)) {
#ifndef RECUR_REPS
#define RECUR_REPS 1
#endif
#ifndef S5B_REPS
#define S5B_REPS 1
#endif
        { int reps = RECUR_REPS; if (RECUR_REPS != 1) asm volatile("" : "+s"(reps));
#pragma unroll 1
          for (int r_ = 0; r_ < reps; ++r_) recur_phase(p, cx, l, (float*)lds, gl); }
        { int reps = S5B_REPS; if (S5B_REPS != 1) asm volatile("" : "+s"(reps));
#pragma unroll 1
          for (int r_ = 0; r_ < reps; ++r_) s5_units<true>(p, cx, l, lds); }
      } else if (s == 3 && PHON(3)) {
        EpiStoreF32 E{(float*)(p->ws + WS_GLUO), 256};
        run_gemm(cx, gl, (const bf16_t*)(p->ws + WS_YSB), (const bf16_t*)(wl + WL_GLU), T_ALL, 256, 256, E, cx.bid);
      } else if (s == 4 && PHON(4)) {
        mix_phase(p, cx, l);
      } else if ((s == 5 || s == 9 || s == 12) && PHON(5)) {
        const bf16_t* A = s == 5 ? (const bf16_t*)(p->ws + WS_MIX) : (s == 9 ? (const bf16_t*)(p->ws + WS_OB) : (const bf16_t*)(p->ws + WS_HID));
        const bf16_t* Bt = (const bf16_t*)(wl + (s == 5 ? WL_OUT : (s == 9 ? WL_O : WL_DOWN)));
        const int Kt = s == 12 ? DFF : DM;
        { EpiRes E{xres}; run_gemm(cx, gl, A, Bt, T_P, DM, Kt, E, cx.bid); }
        { const int nsl = s == 12 ? 16 : 4, Ks = Kt / nsl;
#pragma unroll 1
          for (int c = cx.bid; c < 16 * nsl; c += cx.G) {
            Ctx c2 = cx; asm volatile("" : "+v"(c2.tid));
            OneUnit S; S.valid = 1; const int un = c / nsl, sl = c % nsl; S.pm = un >> 2; S.pn = un & 3;
            pg8::Gemm g{A + (size_t)T_P * Kt + (size_t)sl * Ks, Bt + (size_t)sl * Ks, T_S, DM, Ks, Kt};
            EpiStoreF32 E{(float*)(p->ws + WS_PART) + (size_t)sl * T_S * DM, DM}; pg8::gemm_phase<EpiStoreF32, OneUnit>(gl, g, S, E, c2.tid); } }
      } else if ((s == 6 || s == 10) && PHON(6)) {
        rms_rows<false, false>(cx, xres, xres + (size_t)T_P * DM, (s == 6 ? p->in[I_NMEM] : p->in[I_NFFN]) + l * DM, hA, nullptr, nullptr, (const float*)(p->ws + WS_PART), 4);
      } else if (s == 7 && PHON(7)) {
        { EpiBf<0> E{(bf16_t*)(p->ws + WS_QB), DM}; run_gemm(cx, gl, hA, (const bf16_t*)(wl + WL_Q), T_P, DM, DM, E, cx.bid); }
        { const int nsl = 4, Ks = DM / nsl;
#pragma unroll 1
          for (int c = cx.bid; c < 16 * nsl; c += cx.G) { Ctx c2 = cx; asm volatile("" : "+v"(c2.tid));
            OneUnit S; S.valid = 1; const int un = c / nsl, sl = c % nsl; S.pm = un >> 2; S.pn = un & 3;
            pg8::Gemm g{hA + (size_t)T_P * DM + (size_t)sl * Ks, (const bf16_t*)(wl + WL_Q) + (size_t)sl * Ks, T_S, DM, Ks, DM};
            EpiStoreF32 E{(float*)(p->ws + WS_PART) + (size_t)sl * T_S * DM, DM}; pg8::gemm_phase<EpiStoreF32, OneUnit>(gl, g, S, E, c2.tid); } }
      } else if (s == 8 && PHON(8)) {
        { const int nrd = (1024 + cx.G - 1) / cx.G, rot = (cx.bid & 1) ? nrd / 2 : 0;
          for (int k_ = 0; k_ < nrd; ++k_) { const int u = cx.bid + ((k_ + rot) % nrd) * cx.G; if (u < 1024) { if (u < 512) attn_prompt_unit(p, cx, l, u, lds); else attn_sample_unit(p, cx, l, u - 512, lds); } } }
      } else if (s == 11 && PHON(11)) {
        EpiBf<1> E{(bf16_t*)(p->ws + WS_HID), DFF}; run_gemm(cx, gl, hA, (const bf16_t*)(wl + WL_UP), T_ALL, DFF, DM, E, cx.bid);
      } else if (s == 13 && PHON(13)) {
        if (l == 0) rms_rows<false, false>(cx, xres, xres + (size_t)T_P * DM, p->in[I_NMIX] + DM, hA, nullptr, nullptr, (const float*)(p->ws + WS_PART), 16);
        else rms_rows<true, false>(cx, xres, xres + (size_t)T_P * DM, p->in[I_NFINAL], nullptr, p->out + O_Y, nullptr, (const float*)(p->ws + WS_PART), 16);
      }
    }
    if (ph + 1 < ph_hi) xcd_barrier(xb, cx.tid);
  }
}

extern "C" void kernel_launch(void* const* d_in, const int* in_sizes, int n_in, void* d_out, int out_size, void* d_ws, size_t ws_size, hipStream_t stream) {
  static int grid_blocks = 0;
  if (!grid_blocks) {
    int dev = 0, cus = 0, per_cu = 0;
    (void)hipGetDevice(&dev);
    (void)hipDeviceGetAttribute(&cus, hipDeviceAttributeMultiprocessorCount, dev);
    (void)hipFuncSetAttribute((const void*)mega, hipFuncAttributeMaxDynamicSharedMemorySize, LDS_BYTES);
    (void)hipOccupancyMaxActiveBlocksPerMultiprocessor(&per_cu, (const void*)mega, NTHR, LDS_BYTES);
    if (per_cu < 1) per_cu = 1;
    grid_blocks = cus * per_cu;
    if (n_in != 47 || (size_t)out_size != O_END || ws_size < WS_END) fprintf(stderr, "kernel_launch: unexpected sizes n_in %d out %d ws %zu (need %zu)\n", n_in, out_size, ws_size, (size_t)WS_END);
  }
  Params p{};
  for (int i = 0; i < 47; ++i) p.in[i] = (const float*)d_in[i];
  p.out = (float*)d_out; p.ws = (unsigned char*)d_ws; p.ph_lo = 0; p.ph_hi = NPHASE;
  (void)hipMemsetAsync((char*)d_ws + WS_BAR, 0, XCD_BAR_WORDS * 4, stream);
  void* args[] = {&p};
  hipError_t e = hipLaunchCooperativeKernel((const void*)mega, dim3(grid_blocks), dim3(NTHR), args, LDS_BYTES, stream);
  if (e != hipSuccess) fprintf(stderr, "cooperative launch failed: %s (grid %d)\n", hipGetErrorString(e), grid_blocks);
}
```

```cpp
#include <hip/hip_runtime.h>
#include <hip/hip_cooperative_groups.h>
#include <cstdio>
namespace cg = cooperative_groups;

#define LAS __attribute__((address_space(3)))
typedef unsigned short bf16_t;
typedef float f32x2 __attribute__((ext_vector_type(2)));
typedef unsigned u32x2 __attribute__((ext_vector_type(2)));

constexpr int T_ALL = 17408, T_P = 16384, T_S = 1024, DM = 1024, INW = 3328, DFF = 4096;
constexpr int NTHR = 512;
constexpr int LDS_MAIN = 147456, LDS_BYTES = LDS_MAIN + 16;

constexpr size_t al(size_t x) { return (x + 255) & ~(size_t)255; }
constexpr size_t SZ_WIN = (size_t)INW * DM * 2, SZ_SQ = (size_t)DM * DM * 2, SZ_UP = (size_t)DFF * DM * 2, SZ_GLU = 256 * 256 * 2;
constexpr size_t WL_IN = 0, WL_OUT = WL_IN + SZ_WIN, WL_Q = WL_OUT + SZ_SQ, WL_K = WL_Q + SZ_SQ, WL_V = WL_K + SZ_SQ, WL_O = WL_V + SZ_SQ,
                 WL_UP = WL_O + SZ_SQ, WL_DOWN = WL_UP + SZ_UP, WL_GLU = WL_DOWN + SZ_UP, WL_SIZE = WL_GLU + SZ_GLU;
constexpr size_t WS_WT = 0;
constexpr size_t WS_MEMB = al(WS_WT + 2 * WL_SIZE);
constexpr size_t WS_XRES = al(WS_MEMB + (size_t)2048 * DM * 2);
constexpr size_t WS_HA = al(WS_XRES + (size_t)T_ALL * DM * 4);
constexpr size_t WS_MIX = al(WS_HA + (size_t)T_ALL * DM * 2);
constexpr size_t WS_QB = al(WS_MIX + (size_t)T_ALL * DM * 2);
constexpr size_t WS_OB = al(WS_QB + (size_t)T_ALL * DM * 2);
constexpr size_t WS_HID = al(WS_OB + (size_t)T_ALL * DM * 2);
constexpr size_t WS_PROJ = al(WS_HID + (size_t)T_ALL * DFF * 2);
constexpr size_t WS_REC = al(WS_PROJ + (size_t)T_ALL * INW * 2);
constexpr size_t WS_GATE = al(WS_REC + (size_t)T_ALL * 1536 * 4);
constexpr size_t WS_ORAW = al(WS_GATE + (size_t)T_ALL * 256 * 4);
constexpr size_t WS_YSF = al(WS_ORAW + (size_t)T_ALL * 768 * 4);
constexpr size_t WS_YSB = al(WS_YSF + (size_t)T_ALL * 256 * 4);
constexpr size_t WS_GLUO = al(WS_YSB + (size_t)T_ALL * 256 * 2);
constexpr size_t WS_S5E = al(WS_GLUO + (size_t)T_ALL * 256 * 4);
constexpr size_t WS_S5C = al(WS_S5E + (size_t)8 * 16 * 32 * 128 * 4);
constexpr size_t WS_ROPE = al(WS_S5C + (size_t)2 * 36864 * 4);
constexpr size_t WS_LB = al(WS_ROPE + (size_t)2056 * 64 * 4);
constexpr size_t WS_KB = al(WS_LB + 2 * 256 * 4);
constexpr size_t WS_VT = al(WS_KB + (size_t)2 * 32 * 65536 * 2);
constexpr size_t WS_BAR = al(WS_VT + (size_t)2 * 32 * 65536 * 2);
constexpr size_t WS_LORA = al(WS_BAR + 16384);
constexpr size_t WS_PART = al(WS_LORA + 2 * 65536 * 2);
constexpr size_t WS_END = al(WS_PART + (size_t)16 * T_S * DM * 4);

constexpr size_t O_Y = 0;
constexpr size_t O_PRE = (size_t)T_ALL * DM;
constexpr size_t O_PIM = O_PRE + 16384;
constexpr size_t O_PHG = O_PIM + 16384;
constexpr size_t O_PRT = O_PHG + 262144;
constexpr size_t O_PRW = O_PRT + 262144;
constexpr size_t O_PSH = O_PRW + 262144;
constexpr size_t O_PMK = O_PSH + 16384;
constexpr size_t O_PMV = O_PMK + 4194304;
constexpr size_t O_SRE = O_PMV + 4194304;
constexpr size_t O_SIM = O_SRE + 262144;
constexpr size_t O_SHG = O_SIM + 262144;
constexpr size_t O_SRT = O_SHG + 4194304;
constexpr size_t O_SRW = O_SRT + 4194304;
constexpr size_t O_SSH = O_SRW + 4194304;
constexpr size_t O_END = O_SSH + 262144;

struct Params {
  const float* in[47];
  float* out;
  unsigned char* ws;
  int ph_lo, ph_hi;
};

enum { I_XP = 0, I_XS, I_MEM, I_S5RE, I_S5IM, I_SHG, I_SRT, I_SRW, I_SSHIFT, I_CK, I_CV, I_NMIX, I_WIN, I_WOUT, I_LAMRE, I_LAMIM,
       I_BRE, I_BIM, I_CRE, I_CIM, I_S5D, I_LOGSTEP, I_WGLU, I_BGLU, I_S5NORM, I_LBLOG, I_HGNORM, I_RWMU, I_RWW0, I_RWW2, I_RWA0,
       I_RWA2, I_RWG2, I_RWKK, I_RWKA, I_RWRK, I_RWLNG, I_RWLNB, I_NMEM, I_WQ, I_WK, I_WV, I_WO, I_NFFN, I_WUP, I_WDOWN, I_NFINAL };

__device__ __forceinline__ unsigned short f2bf(float f) { unsigned u = __float_as_uint(f); u += 0x7FFFu + ((u >> 16) & 1u); return (unsigned short)(u >> 16); }
__device__ __forceinline__ unsigned pack2(float lo, float hi) { return (unsigned)f2bf(lo) | ((unsigned)f2bf(hi) << 16); }
__device__ __forceinline__ float bf2f(unsigned short b) { return __uint_as_float(((unsigned)b) << 16); }
__device__ __forceinline__ float4 ld4(const bf16_t* q) { const u32x2 v = *(const u32x2*)q; float4 r; r.x = __uint_as_float(v.x << 16); r.y = __uint_as_float(v.x & 0xffff0000u); r.z = __uint_as_float(v.y << 16); r.w = __uint_as_float(v.y & 0xffff0000u); return r; }
__device__ __forceinline__ float4 cv4(const u32x2 v) { float4 r; r.x = __uint_as_float(v.x << 16); r.y = __uint_as_float(v.x & 0xffff0000u); r.z = __uint_as_float(v.y << 16); r.w = __uint_as_float(v.y & 0xffff0000u); return r; }
__device__ __forceinline__ float sigm(float x) { return __builtin_amdgcn_rcpf(1.0f + __expf(-x)); }
__device__ __forceinline__ float siluf(float x) { return x * sigm(x); }
__device__ __forceinline__ float row_sum16(float x) {
  x += __int_as_float(__builtin_amdgcn_update_dpp(0, __float_as_int(x), 0x128, 0xf, 0xf, false));
  x += __int_as_float(__builtin_amdgcn_update_dpp(0, __float_as_int(x), 0x124, 0xf, 0xf, false));
  x += __int_as_float(__builtin_amdgcn_update_dpp(0, __float_as_int(x), 0x122, 0xf, 0xf, false));
  x += __int_as_float(__builtin_amdgcn_update_dpp(0, __float_as_int(x), 0x121, 0xf, 0xf, false));
  return x;
}
__device__ __forceinline__ float shx(float x, int off, int lane) { return __int_as_float(__builtin_amdgcn_ds_bpermute((lane ^ off) << 2, __float_as_int(x))); }
__device__ __forceinline__ float wave_sum(float x, int lane) { x = row_sum16(x); x += shx(x, 16, lane); x += shx(x, 32, lane); return x; }
__device__ __forceinline__ float wave_max(float x, int lane) {
#pragma unroll
  for (int o = 32; o >= 1; o >>= 1) x = fmaxf(x, shx(x, o, lane));
  return x;
}
__device__ __forceinline__ void dsincos(double x, double& s, double& c) {
  const double n = rint(x * 0.15915494309189535);
  double r = (x - n * 6.283185307179586) * 0.125;
  const double r2 = r * r;
  double sn = r * (1.0 - r2 / 6.0 * (1.0 - r2 / 20.0 * (1.0 - r2 / 42.0 * (1.0 - r2 / 72.0 * (1.0 - r2 / 110.0 * (1.0 - r2 / 156.0))))));
  double cs = 1.0 - r2 / 2.0 * (1.0 - r2 / 12.0 * (1.0 - r2 / 30.0 * (1.0 - r2 / 56.0 * (1.0 - r2 / 90.0 * (1.0 - r2 / 132.0)))));
#pragma unroll
  for (int i = 0; i < 3; ++i) { const double s2 = 2.0 * sn * cs, c2 = 1.0 - 2.0 * sn * sn; sn = s2; cs = c2; }
  s = sn; c = cs;
}

typedef const __attribute__((address_space(4))) Params* KP;
__device__ __forceinline__ KP get_params() { KP k = (KP)__builtin_amdgcn_kernarg_segment_ptr(); asm volatile("" : "+s"(k)); return k; }
namespace pg8 {
#define PG8_LAS __attribute__((address_space(3)))
typedef unsigned short bf16_t;
typedef short bf16x8 __attribute__((ext_vector_type(8)));
typedef float f32x4 __attribute__((ext_vector_type(4)));
typedef unsigned u32x4 __attribute__((ext_vector_type(4)));
constexpr int BM = 256, BK = 64, HALF = 128, HTB = HALF * BK * 2  , STAGE_BYTES = 8 * HTB, NXCD = 8, WGM = 8;

__host__ __device__ __forceinline__ int lds_byte(int r, int c) { const int st = (r >> 4) * 2 + (c >> 5), rr = r & 15, cc = c & 31, ob = rr * 64 + cc * 2; return st * 1024 + (ob ^ (((ob >> 9) & 1) << 5)); }
__host__ __device__ __forceinline__ void stage_rc(int b, int& R, int& C) { const int st = b / 1024, sb = b % 1024, swz = sb ^ (((sb >> 9) & 1) << 5); R = (st >> 1) * 16 + swz / 64; C = (st & 1) * 32 + (swz % 64) / 2; }
__host__ __device__ __forceinline__ int perm32(int rho) { const int n = rho >> 4, i = rho & 15; return 8 * (i >> 2) + 4 * n + (i & 3); }

struct Unit { int pm, pn; };
struct Gemm { const bf16_t* A; const bf16_t* Bt; int M, N, K, ld; };

struct StaticOrder {
    int nM, nN, nwg, G, c;
    __host__ __device__ void init(int M, int N, int G_, int c_) { nM = M / BM; nN = N / BM; nwg = nM * nN; G = G_; c = c_; }
    __host__ __device__ bool next(int i, Unit& u) const {
        const long L = (long)i * G + c; if (L >= nwg) return false;
        int wgid = (int)L; { const int q = nwg / NXCD, r = nwg % NXCD, xcd = wgid % NXCD, off = wgid / NXCD; wgid = (xcd < r ? xcd * (q + 1) : r * (q + 1) + (xcd - r) * q) + off; }
        const int nig = WGM * nN, gid = wgid / nig, fm = gid * WGM, gsz = (nM - fm) < WGM ? (nM - fm) : WGM;
        u.pm = fm + ((wgid % nig) % gsz); u.pn = (wgid % nig) / gsz; return true;
    }
    __device__ __forceinline__ void a_ready(const Unit&) const {}
    __device__ __forceinline__ void done(const Unit&) const {}
};
__device__ __forceinline__ unsigned cvt_pk_bf16(float lo, float hi) { unsigned r; asm volatile("v_cvt_pk_bf16_f32 %0, %1, %2" : "=v"(r) : "v"(lo), "v"(hi)); return r; }
typedef float f32x2 __attribute__((ext_vector_type(2)));
__device__ __forceinline__ f32x2 gelu_pk(f32x2 v) {
    const f32x2 av = __builtin_elementwise_abs(v), d = av * 0.2316418882f + 1.0f;
    f32x2 t; t.x = __builtin_amdgcn_rcpf(d.x); t.y = __builtin_amdgcn_rcpf(d.y);
    f32x2 q = t * 0.5307027145f + (-0.7265760135f); q = q * t + 0.7107068705f; q = q * t + (-0.142248368f); q = q * t + 0.127414796f; q = q * t;
    const f32x2 s = (v * v) * (-0.72134752044f);
    f32x2 e; e.x = __builtin_amdgcn_exp2f(s.x); e.y = __builtin_amdgcn_exp2f(s.y);
    const f32x2 m = v * (q * e), r = v - m;
    f32x2 o; o.x = v.x < 0.f ? m.x : r.x; o.y = v.y < 0.f ? m.y : r.y; return o;
}
template <class Epi, class Sched>
__device__ __forceinline__ void gemm_phase(PG8_LAS unsigned char* lds, const Gemm g, const Sched& S, const Epi& E, const int tid_in) {
    const int tid = tid_in, wid = __builtin_amdgcn_readfirstlane(tid >> 6), lane = tid & 63, wr = wid >> 2, wc = wid & 3, fr = lane & 15, fq = lane >> 4;
    const int K = g.K, nt = K / BK, LD = g.ld;
    unsigned voffA[2], voffB[2];
#pragma unroll
    for (int i = 0; i < 2; ++i) { int R, C; stage_rc(tid * 16 + i * 8192, R, C); const int Rb = Epi::PERM ? ((R & ~31) + perm32(R & 31)) : R;
        voffA[i] = (unsigned)(R * LD + C) * 2u; voffB[i] = (unsigned)(Rb * LD + C) * 2u; }
    const size_t kstep = (size_t)(BK * 2);
    const size_t hstep = (size_t)HALF * LD * 2;
    const size_t tstep = 2 * hstep;
    const unsigned ldsw = (unsigned)wid * 1024u;
    const int aoff = lds_byte(wr * 64 + fr, fq * 8), boff = lds_byte(wc * 32 + fr, fq * 8);
#define PG8_SA(b, h) (((b) * 2 + (h)) * HTB)
#define PG8_SB(b, h) ((4 + (b) * 2 + (h)) * HTB)
#define PG8_STAGE(bufoff, gbase, voff) do { _Pragma("unroll") for (int _i = 0; _i < 2; ++_i) \
        __builtin_amdgcn_global_load_lds((const unsigned*)((const char*)(gbase) + (voff)[_i]), (PG8_LAS unsigned*)(lds + (bufoff) + ldsw + _i * 8192), 16, 0, 0); } while (0)
#define PG8_LDA(dst, b, h) do { _Pragma("unroll") for (int m = 0; m < 4; ++m) _Pragma("unroll") for (int k = 0; k < 2; ++k) dst[m][k] = *(const PG8_LAS bf16x8*)(lds + PG8_SA(b, h) + aoff + m * 2048 + k * 1024); } while (0)
#define PG8_LDB(dst, b, h) do { _Pragma("unroll") for (int n = 0; n < 2; ++n) _Pragma("unroll") for (int k = 0; k < 2; ++k) dst[n][k] = *(const PG8_LAS bf16x8*)(lds + PG8_SB(b, h) + boff + n * 2048 + k * 1024); } while (0)
#define PG8_MMA(ai, bj, At, Bt) do { __builtin_amdgcn_s_setprio(1); _Pragma("unroll") for (int m = 0; m < 4; ++m) _Pragma("unroll") for (int n = 0; n < 2; ++n) _Pragma("unroll") for (int k = 0; k < 2; ++k) \
        acc[ai][bj][m][n] = __builtin_amdgcn_mfma_f32_16x16x32_bf16(Bt[n][k], At[m][k], acc[ai][bj][m][n], 0, 0, 0); __builtin_amdgcn_s_setprio(0); } while (0)
#define PG8_WAIT_V(n) asm volatile("s_waitcnt vmcnt(" #n ")" ::: "memory")
#define PG8_WAIT_L(n) asm volatile("s_waitcnt lgkmcnt(" #n ")" ::: "memory")
#define PG8_BAR __builtin_amdgcn_s_barrier()
#define PG8_SCHED __builtin_amdgcn_sched_barrier(0)
    Unit cur, nxt; int ui = 0;
    if (!S.next(0, cur)) return;
    f32x4 acc[2][2][4][2];
#pragma unroll
    for (int a = 0; a < 2; ++a)
#pragma unroll
        for (int b = 0; b < 2; ++b)
#pragma unroll
            for (int m = 0; m < 4; ++m)
#pragma unroll
                for (int n = 0; n < 2; ++n) acc[a][b][m][n] = (f32x4){0.f, 0.f, 0.f, 0.f};
    bf16x8 At[4][2], B0[2][2], B1[2][2];
    const char* cA = (const char*)g.A + (size_t)cur.pm * tstep; const char* cB = (const char*)g.Bt + (size_t)cur.pn * tstep;
    S.a_ready(cur);
    PG8_STAGE(PG8_SB(0, 0), cB, voffB); PG8_STAGE(PG8_SA(0, 0), cA, voffA); PG8_STAGE(PG8_SB(0, 1), cB + hstep, voffB); PG8_STAGE(PG8_SA(0, 1), cA + hstep, voffA);
    if (wr == 1) PG8_BAR;
    PG8_WAIT_V(4); PG8_BAR;
    PG8_STAGE(PG8_SB(1, 0), cB + kstep, voffB); PG8_STAGE(PG8_SA(1, 0), cA + kstep, voffA); PG8_STAGE(PG8_SB(1, 1), cB + hstep + kstep, voffB);
    PG8_WAIT_V(6); PG8_BAR;
    for (;;) {
        const bool has_next = S.next(ui + 1, nxt);
        const char* nA = has_next ? (const char*)g.A + (size_t)nxt.pm * tstep : cA; const char* nB = has_next ? (const char*)g.Bt + (size_t)nxt.pn * tstep : cB;
        for (int t = 0; t < nt; t += 2) {
            const bool last = (t == nt - 2);
            const char* a1 = cA + (size_t)(t + 1) * kstep;
            const char* a2 = last ? nA : cA + (size_t)(t + 2) * kstep; const char* b2 = last ? nB : cB + (size_t)(t + 2) * kstep;
            const char* a3 = a2 + kstep; const char* b3 = b2 + kstep;
            if (last && has_next) S.a_ready(nxt);
            PG8_LDB(B0, 0, 0); PG8_SCHED; PG8_LDA(At, 0, 0); PG8_STAGE(PG8_SA(1, 1), a1 + hstep, voffA);
            PG8_WAIT_L(8); PG8_BAR; PG8_WAIT_L(0); PG8_MMA(0, 0, At, B0); PG8_BAR; PG8_SCHED;
            PG8_LDB(B1, 0, 1); PG8_STAGE(PG8_SB(0, 0), b2, voffB);
            PG8_BAR; PG8_WAIT_L(0); PG8_MMA(0, 1, At, B1); PG8_BAR;
            PG8_LDA(At, 0, 1); PG8_STAGE(PG8_SA(0, 0), a2, voffA);
            PG8_BAR; PG8_WAIT_L(0); PG8_MMA(1, 0, At, B0); PG8_BAR; PG8_SCHED;
            PG8_STAGE(PG8_SB(0, 1), b2 + hstep, voffB);
            PG8_WAIT_V(6); PG8_BAR; PG8_MMA(1, 1, At, B1); PG8_BAR;
            PG8_LDB(B0, 1, 0); PG8_SCHED; PG8_LDA(At, 1, 0); PG8_STAGE(PG8_SA(0, 1), a2 + hstep, voffA);
            PG8_WAIT_L(8); PG8_BAR; PG8_WAIT_L(0); PG8_MMA(0, 0, At, B0); PG8_BAR; PG8_SCHED;
            PG8_LDB(B1, 1, 1); PG8_STAGE(PG8_SB(1, 0), b3, voffB);
            PG8_BAR; PG8_WAIT_L(0); PG8_MMA(0, 1, At, B1); PG8_BAR;
            PG8_LDA(At, 1, 1); PG8_STAGE(PG8_SA(1, 0), a3, voffA);
            PG8_BAR; PG8_WAIT_L(0); PG8_MMA(1, 0, At, B0); PG8_BAR; PG8_SCHED;
            PG8_STAGE(PG8_SB(1, 1), b3 + hstep, voffB);
            PG8_WAIT_V(6); PG8_BAR; PG8_MMA(1, 1, At, B1); PG8_BAR;
        }
        if constexpr (!Epi::AFTER_DRAIN) { E(acc, cur, wr, wc, fr, fq); S.done(cur); }
        if (!has_next) break;
#pragma unroll
        for (int a = 0; a < 2; ++a)
#pragma unroll
            for (int b = 0; b < 2; ++b)
#pragma unroll
                for (int m = 0; m < 4; ++m)
#pragma unroll
                    for (int n = 0; n < 2; ++n) acc[a][b][m][n] = (f32x4){0.f, 0.f, 0.f, 0.f};
        cur = nxt; cA = nA; cB = nB; ++ui;
    }
    PG8_WAIT_V(0);
    if (wr == 0) PG8_BAR;
    PG8_BAR;
    if constexpr (Epi::AFTER_DRAIN) { E.fused(acc, cur, wr, wc, fr, fq, lds, wid, lane); S.done(cur); }
#undef PG8_SA
#undef PG8_SB
#undef PG8_STAGE
#undef PG8_LDA
#undef PG8_LDB
#undef PG8_MMA
#undef PG8_WAIT_V
#undef PG8_WAIT_L
#undef PG8_BAR
#undef PG8_SCHED
}
}

struct Ctx { int tid, bid, G; };
using pg8::bf16x8; using pg8::f32x4; using pg8::u32x4; using pg8::Unit; using pg8::cvt_pk_bf16;
constexpr int HALF = 128;

struct EpiStoreF32 {
  static constexpr bool PERM = false, AFTER_DRAIN = false;
  float* C; int ldc;
  __device__ __forceinline__ void operator()(const f32x4 (&acc)[2][2][4][2], const Unit& u, int wr, int wc, int fr, int fq) const {
    const int row0 = u.pm * 256 + wr * 64 + fr, col0 = u.pn * 256 + wc * 32 + 4 * fq;
#pragma unroll
    for (int ai = 0; ai < 2; ++ai)
#pragma unroll
      for (int m = 0; m < 4; ++m) { float* rowp = C + (size_t)(row0 + ai * HALF + m * 16) * ldc + col0;
#pragma unroll
        for (int bj = 0; bj < 2; ++bj)
#pragma unroll
          for (int n = 0; n < 2; ++n) *(f32x4*)(rowp + bj * HALF + n * 16) = acc[ai][bj][m][n]; }
  }
};
struct EpiRes {
  static constexpr bool PERM = false, AFTER_DRAIN = false;
  float* X;
  __device__ __forceinline__ void operator()(const f32x4 (&acc)[2][2][4][2], const Unit& u, int wr, int wc, int fr, int fq) const {
    const int row0 = u.pm * 256 + wr * 64 + fr, col0 = u.pn * 256 + wc * 32 + 4 * fq;
#pragma unroll
    for (int ai = 0; ai < 2; ++ai)
#pragma unroll
      for (int m = 0; m < 4; ++m) { float* rowp = X + (size_t)(row0 + ai * HALF + m * 16) * DM + col0;
        f32x4 o[2][2];
#pragma unroll
        for (int bj = 0; bj < 2; ++bj)
#pragma unroll
          for (int n = 0; n < 2; ++n) o[bj][n] = *(const f32x4*)(rowp + bj * HALF + n * 16);
#pragma unroll
        for (int bj = 0; bj < 2; ++bj)
#pragma unroll
          for (int n = 0; n < 2; ++n) *(f32x4*)(rowp + bj * HALF + n * 16) = o[bj][n] + acc[ai][bj][m][n];
        asm volatile("" ::: "memory"); }
  }
};
template <int ACT> struct EpiBf {
  static constexpr bool PERM = true, AFTER_DRAIN = false;
  bf16_t* O; int ldc;
  __device__ __forceinline__ void operator()(const f32x4 (&acc)[2][2][4][2], const Unit& u, int wr, int wc, int fr, int fq) const {
    const int row0 = u.pm * 256 + wr * 64 + fr, col0 = u.pn * 256 + wc * 32 + 8 * fq;
#pragma unroll
    for (int ai = 0; ai < 2; ++ai)
#pragma unroll
      for (int m = 0; m < 4; ++m) { bf16_t* rowp = O + (size_t)(row0 + ai * HALF + m * 16) * ldc + col0;
#pragma unroll
        for (int bj = 0; bj < 2; ++bj) { f32x4 v0 = acc[ai][bj][m][0], v1 = acc[ai][bj][m][1];
          if (ACT == 1) {
#pragma unroll
            for (int j = 0; j < 4; ++j) { const float a = fmaxf(v0[j], 0.f), b = fmaxf(v1[j], 0.f); v0[j] = a * a; v1[j] = b * b; } }
          u32x4 w; w.x = cvt_pk_bf16(v0[0], v0[1]); w.y = cvt_pk_bf16(v0[2], v0[3]); w.z = cvt_pk_bf16(v1[0], v1[1]); w.w = cvt_pk_bf16(v1[2], v1[3]);
          *(u32x4*)(rowp + bj * HALF) = w; } }
  }
};
struct EpiMemK {
  static constexpr bool PERM = false, AFTER_DRAIN = false;
  float* C; bf16_t* Kb;
  __device__ __forceinline__ void operator()(const f32x4 (&acc)[2][2][4][2], const Unit& u, int wr, int wc, int fr, int fq) const {
    const int rl0 = wr * 64 + fr, cl0 = wc * 32 + 4 * fq;
    bf16_t* kb = Kb + (size_t)(u.pm * 4 + u.pn) * 65536;
#pragma unroll
    for (int ai = 0; ai < 2; ++ai)
#pragma unroll
      for (int m = 0; m < 4; ++m) { const int rl = rl0 + ai * HALF + m * 16; float* rowp = C + (size_t)(u.pm * 256 + rl) * DM + u.pn * 256 + cl0;
#pragma unroll
        for (int bj = 0; bj < 2; ++bj)
#pragma unroll
          for (int n = 0; n < 2; ++n) { const f32x4 v = acc[ai][bj][m][n]; *(f32x4*)(rowp + bj * HALF + n * 16) = v;
            u32x2 w; w.x = cvt_pk_bf16(v[0], v[1]); w.y = cvt_pk_bf16(v[2], v[3]); *(u32x2*)(kb + rl * 256 + cl0 + bj * HALF + n * 16) = w; } }
  }
};
struct EpiVt {
  static constexpr bool PERM = true, AFTER_DRAIN = false;
  bf16_t* Vt;
  __device__ __forceinline__ void operator()(const f32x4 (&acc)[2][2][4][2], const Unit& u, int wr, int wc, int fr, int fq) const {
    bf16_t* vt = Vt + (size_t)(u.pn * 4 + u.pm) * 65536; const int rl0 = wr * 64 + fr, cl0 = wc * 32 + 8 * fq;
#pragma unroll
    for (int ai = 0; ai < 2; ++ai)
#pragma unroll
      for (int m = 0; m < 4; ++m) { bf16_t* rowp = vt + (rl0 + ai * HALF + m * 16) * 256 + cl0;
#pragma unroll
        for (int bj = 0; bj < 2; ++bj) { const f32x4 v0 = acc[ai][bj][m][0], v1 = acc[ai][bj][m][1];
          u32x4 w; w.x = cvt_pk_bf16(v0[0], v0[1]); w.y = cvt_pk_bf16(v0[2], v0[3]); w.z = cvt_pk_bf16(v1[0], v1[1]); w.w = cvt_pk_bf16(v1[2], v1[3]);
          *(u32x4*)(rowp + bj * HALF) = w; } }
  }
};
template <class Epi>
__device__ __forceinline__ void run_gemm(const Ctx cx0, LAS unsigned char* lds, const bf16_t* A, const bf16_t* Bt, int M, int N, int K, const Epi& E, int cid) {
  Ctx cx = cx0; asm volatile("" : "+v"(cx.tid));
  pg8::Gemm g{A, Bt, M, N, K, K}; pg8::StaticOrder S; S.init(M, N, cx.G, cid);
  pg8::gemm_phase<Epi, pg8::StaticOrder>(lds, g, S, E, cx.tid);
}
struct OneUnit {
  int pm, pn, valid;
  __device__ bool next(int i, Unit& u) const { if (i == 0 && valid) { u.pm = pm; u.pn = pn; return true; } return false; }
  __device__ __forceinline__ void a_ready(const Unit&) const {}
  __device__ __forceinline__ void done(const Unit&) const {}
};
struct EpiResAtomic {
  static constexpr bool PERM = false, AFTER_DRAIN = false;
  float* X;
  __device__ __forceinline__ void operator()(const f32x4 (&acc)[2][2][4][2], const Unit& u, int wr, int wc, int fr, int fq) const {
    const int row0 = u.pm * 256 + wr * 64 + fr, col0 = u.pn * 256 + wc * 32 + 4 * fq;
#pragma unroll
    for (int ai = 0; ai < 2; ++ai)
#pragma unroll
      for (int m = 0; m < 4; ++m) { float* rowp = X + (size_t)(row0 + ai * HALF + m * 16) * DM + col0;
#pragma unroll
        for (int bj = 0; bj < 2; ++bj)
#pragma unroll
          for (int n = 0; n < 2; ++n)
#pragma unroll
            for (int j = 0; j < 4; ++j) atomicAdd(rowp + bj * HALF + n * 16 + j, acc[ai][bj][m][n][j]); }
  }
};

template <bool FINAL, bool COPY>
__device__ void rms_rows(const Ctx cx, const float* srcA, const float* srcB, const float* gain, bf16_t* outb, float* outf, float* xres, const float* part, int npart) {
  const int lane = cx.tid & 63, gw = cx.bid * 8 + (cx.tid >> 6), nw = cx.G * 8;
  float4 g[4];
#pragma unroll
  for (int q = 0; q < 4; ++q) g[q] = *(const float4*)(gain + q * 256 + lane * 4);
  float4 nv[4];
  if (gw < T_ALL) { const float* s0_ = (gw < T_P) ? srcA + (size_t)gw * DM : srcB + (size_t)(gw - T_P) * DM;
#pragma unroll
    for (int q = 0; q < 4; ++q) nv[q] = *(const float4*)(s0_ + q * 256 + lane * 4); }
  for (int t = gw; t < T_ALL; t += nw) {
    const float* src = (t < T_P) ? srcA + (size_t)t * DM : srcB + (size_t)(t - T_P) * DM;
    float4 v[4]; float ss = 0.f;
#pragma unroll
    for (int q = 0; q < 4; ++q) v[q] = nv[q];
    { const int tn = t + nw; if (tn < T_ALL) { const float* sn_ = (tn < T_P) ? srcA + (size_t)tn * DM : srcB + (size_t)(tn - T_P) * DM;
#pragma unroll
        for (int q = 0; q < 4; ++q) nv[q] = *(const float4*)(sn_ + q * 256 + lane * 4); } }
    if (npart > 0 && t >= T_P) {
      for (int s_ = 0; s_ < npart; ++s_) { const float* pp = part + ((size_t)s_ * T_S + (t - T_P)) * DM;
#pragma unroll
        for (int q = 0; q < 4; ++q) { const float4 a = *(const float4*)(pp + q * 256 + lane * 4); v[q].x += a.x; v[q].y += a.y; v[q].z += a.z; v[q].w += a.w; } }
#pragma unroll
      for (int q = 0; q < 4; ++q) *(float4*)((float*)src + q * 256 + lane * 4) = v[q];
    }
#pragma unroll
    for (int q = 0; q < 4; ++q) { ss += v[q].x * v[q].x + v[q].y * v[q].y + v[q].z * v[q].z + v[q].w * v[q].w; }
    ss = wave_sum(ss, lane);
    const float r = rsqrtf(ss * (1.0f / 1024.0f) + 1e-6f);
#pragma unroll
    for (int q = 0; q < 4; ++q) {
      if (COPY) *(float4*)(xres + (size_t)t * DM + q * 256 + lane * 4) = v[q];
      const float a = v[q].x * r * g[q].x, b = v[q].y * r * g[q].y, c = v[q].z * r * g[q].z, d = v[q].w * r * g[q].w;
      if (FINAL) { float4 o; o.x = a; o.y = b; o.z = c; o.w = d; *(float4*)(outf + (size_t)t * DM + q * 256 + lane * 4) = o; }
      else { u32x2 w; w.x = pack2(a, b); w.y = pack2(c, d); *(u32x2*)(outb + (size_t)t * DM + q * 256 + lane * 4) = w; }
    }
  }
}

struct TDesc { const float* s0; const float* s1; bf16_t* dst; };
__device__ __forceinline__ TDesc tile_desc(KP p, int u, int tid) {
    const int l = u / 4192, r = u % 4192; int ldt = 0, koff = 0;
    bf16_t* wl = (bf16_t*)(p->ws + WS_WT + (size_t)l * WL_SIZE);
    const float* W; int K, N; bf16_t* Wt; int tt;
    if (r < 832) { W = p->in[I_WIN] + (size_t)l * DM * INW; K = DM; N = INW; Wt = (bf16_t*)((unsigned char*)wl + WL_IN); tt = r; }
    else if (r < 1088) { W = p->in[I_WOUT] + (size_t)l * DM * DM; K = DM; N = DM; Wt = (bf16_t*)((unsigned char*)wl + WL_OUT); tt = r - 832; }
    else if (r < 1344) { W = p->in[I_WQ] + (size_t)l * DM * DM; K = DM; N = DM; Wt = (bf16_t*)((unsigned char*)wl + WL_Q); tt = r - 1088; }
    else if (r < 1600) { W = p->in[I_WK] + (size_t)l * DM * DM; K = DM; N = DM; Wt = (bf16_t*)((unsigned char*)wl + WL_K); tt = r - 1344; }
    else if (r < 1856) { W = p->in[I_WV] + (size_t)l * DM * DM; K = DM; N = DM; Wt = (bf16_t*)((unsigned char*)wl + WL_V); tt = r - 1600; }
    else if (r < 2112) { W = p->in[I_WO] + (size_t)l * DM * DM; K = DM; N = DM; Wt = (bf16_t*)((unsigned char*)wl + WL_O); tt = r - 1856; }
    else if (r < 3136) { W = p->in[I_WUP] + (size_t)l * DM * DFF; K = DM; N = DFF; Wt = (bf16_t*)((unsigned char*)wl + WL_UP); tt = r - 2112; }
    else if (r < 4160) { W = p->in[I_WDOWN] + (size_t)l * DFF * DM; K = DFF; N = DM; Wt = (bf16_t*)((unsigned char*)wl + WL_DOWN); tt = r - 3136; }
    else if (r < 4176) { W = p->in[I_WGLU] + (size_t)l * 65536; K = 256; N = 256; Wt = (bf16_t*)((unsigned char*)wl + WL_GLU); tt = r - 4160; }
    else if (r < 4180) { W = p->in[I_RWW2] + (size_t)l * 64 * 256; K = 64; N = 256; Wt = (bf16_t*)(p->ws + WS_LORA) + (size_t)l * 65536; tt = r - 4176; ldt = 256; koff = 0; }
    else if (r < 4184) { W = p->in[I_RWA2] + (size_t)l * 64 * 256; K = 64; N = 256; Wt = (bf16_t*)(p->ws + WS_LORA) + (size_t)l * 65536; tt = r - 4180; ldt = 256; koff = 64; }
    else { W = p->in[I_RWG2] + (size_t)l * 128 * 256; K = 128; N = 256; Wt = (bf16_t*)(p->ws + WS_LORA) + (size_t)l * 65536; tt = r - 4184; ldt = 256; koff = 128; }
    if (ldt == 0) ldt = K;
    const int ntn = N / 64, tk = tt / ntn, tn = tt % ntn;
    TDesc d; d.s0 = W + (size_t)(tk * 64 + (tid >> 4)) * N + tn * 64 + (tid & 15) * 4; d.s1 = d.s0 + (size_t)32 * N;
    d.dst = Wt + (size_t)(tn * 64 + (tid >> 3)) * ldt + koff + tk * 64 + (tid & 7) * 8; return d;
}
__device__ void phase_prep(KP p, const Ctx cx, unsigned char* ldsraw) {
  const int tid = cx.tid;
  float* tl = (float*)ldsraw;
  { int u = cx.bid; TDesc d = tile_desc(p, u < 2 * 4192 ? u : 0, tid); float4 va = *(const float4*)d.s0, vb = *(const float4*)d.s1;
    for (; u < 2 * 4192; u += cx.G) {
      const int un = u + cx.G; const bool hn = un < 2 * 4192; TDesc dn = tile_desc(p, hn ? un : u, tid); float4 na = va, nb = vb;
      if (hn) { na = *(const float4*)dn.s0; nb = *(const float4*)dn.s1; }
      { const int k = tid >> 4, nc = (tid & 15) * 4;
        tl[k * 65 + nc] = va.x; tl[k * 65 + nc + 1] = va.y; tl[k * 65 + nc + 2] = va.z; tl[k * 65 + nc + 3] = va.w;
        tl[(k + 32) * 65 + nc] = vb.x; tl[(k + 32) * 65 + nc + 1] = vb.y; tl[(k + 32) * 65 + nc + 2] = vb.z; tl[(k + 32) * 65 + nc + 3] = vb.w; }
      __syncthreads();
      { const int n = tid >> 3, kc = (tid & 7) * 8; u32x4 w;
        w.x = pack2(tl[(kc + 0) * 65 + n], tl[(kc + 1) * 65 + n]); w.y = pack2(tl[(kc + 2) * 65 + n], tl[(kc + 3) * 65 + n]);
        w.z = pack2(tl[(kc + 4) * 65 + n], tl[(kc + 5) * 65 + n]); w.w = pack2(tl[(kc + 6) * 65 + n], tl[(kc + 7) * 65 + n]);
        *(u32x4*)d.dst = w; }
      __syncthreads();
      d = dn; va = na; vb = nb;
    }
  }
  const int gid = cx.bid * NTHR + tid, gsz = cx.G * NTHR;
  { const float* mem = p->in[I_MEM]; bf16_t* mb = (bf16_t*)(p->ws + WS_MEMB);
    for (int i = gid; i < 2048 * DM / 4; i += gsz) { const float4 v = *(const float4*)(mem + (size_t)i * 4); u32x2 w; w.x = pack2(v.x, v.y); w.y = pack2(v.z, v.w); *(u32x2*)(mb + (size_t)i * 4) = w; } }
  for (int i = gid; i < 2048; i += gsz) {
    const int l = (int)(i >> 10), gp = (int)(i & 1023), g = gp >> 6;
    float* cst = (float*)(p->ws + WS_S5C) + (size_t)l * 36864;
    const double lre = (double)p->in[I_LAMRE][l * 1024 + gp], lim = (double)p->in[I_LAMIM][l * 1024 + gp];
    const double step = exp((double)p->in[I_LOGSTEP][l * 16 + g]);
    double sn, cs; dsincos(lim * step, sn, cs);
    const double mag = exp(lre * step), bre_ = mag * cs, bim_ = mag * sn;
    cst[gp] = (float)bre_; cst[1024 + gp] = (float)bim_;
    double pr = bre_, pi = bim_;
#pragma unroll 1
    for (int q = 0; q < 6; ++q) { const double nr = pr * pr - pi * pi, ni = 2.0 * pr * pi; pr = nr; pi = ni; }
    cst[2048 + gp] = (float)pr; cst[3072 + gp] = (float)pi;
    const double nr_ = bre_ - 1.0, ni_ = bim_, den = lre * lre + lim * lim;
    const double fr_ = (nr_ * lre + ni_ * lim) / den, fi_ = (ni_ * lre - nr_ * lim) / den;
    for (int h = 0; h < 16; ++h) { const double br = (double)p->in[I_BRE][((size_t)l * 1024 + gp) * 16 + h], bi = (double)p->in[I_BIM][((size_t)l * 1024 + gp) * 16 + h];
      cst[4096 + gp * 16 + h] = (float)(fr_ * br - fi_ * bi); cst[4096 + 16384 + gp * 16 + h] = (float)(fr_ * bi + fi_ * br); }
  }
  for (int i = gid; i < 2056 * 32; i += gsz) {
    const int pi_ = (int)(i >> 5), j = (int)(i & 31);
    const float inv = (float)exp(-(double)j * (1.0 / 32.0) * 9.210340371976184);
    const float pos = (float)(pi_ < 2048 ? pi_ : 16384 + (pi_ - 2048));
    const float ang = pos * inv; double sn, cs; dsincos((double)ang, sn, cs);
    float* rp = (float*)(p->ws + WS_ROPE) + (size_t)pi_ * 64; rp[j] = (float)cs; rp[32 + j] = (float)sn;
  }
  rms_rows<false, true>(cx, p->in[I_XP], p->in[I_XS], p->in[I_NMIX], (bf16_t*)(p->ws + WS_HA), nullptr, (float*)(p->ws + WS_XRES), nullptr, 0);
}

__device__ __forceinline__ float tanh_(float x) { return 1.0f - 2.0f / (1.0f + __expf(2.0f * x)); }
__device__ void rwkv_prep(KP p, const Ctx cx, int l, unsigned char* ldsraw) {
  float* pm = (float*)ldsraw; bf16_t* actb = (bf16_t*)(ldsraw + 65536); float* part = (float*)(ldsraw + 65536 + 8448);
  const bf16_t* proj = (const bf16_t*)(p->ws + WS_PROJ); float* rec = (float*)(p->ws + WS_REC); float* gate = (float*)(p->ws + WS_GATE);
  const float* mu = p->in[I_RWMU] + l * 1024; const bf16_t* lw = (const bf16_t*)(p->ws + WS_LORA) + (size_t)l * 65536;
  const int tid = cx.tid, w = tid >> 6, lane = tid & 63, fr = lane & 15, kg = lane >> 4, head = w >> 1;
  bf16x8 bw[2][8]; float w0[2], a0[2], kkc[2], kac[2];
#pragma unroll
  for (int nt = 0; nt < 2; ++nt) { const int c = w * 32 + nt * 16 + fr;
#pragma unroll
    for (int ks = 0; ks < 8; ++ks) bw[nt][ks] = *(const bf16x8*)(lw + (size_t)c * 256 + ks * 32 + kg * 8);
    w0[nt] = p->in[I_RWW0][l * 256 + c]; a0[nt] = p->in[I_RWA0][l * 256 + c]; kkc[nt] = p->in[I_RWKK][l * 256 + c]; kac[nt] = p->in[I_RWKA][l * 256 + c]; }
  for (int tile = cx.bid; tile < T_ALL / 16; tile += cx.G) {
    const int t0 = tile * 16;
    {
      const int c4 = (tid & 255) * 4, g8 = (tid >> 8) * 8; const float4 m = *(const float4*)(mu + c4);
      float4 row[9];
#pragma unroll
      for (int k = 0; k < 8; ++k) row[k + 1] = ld4(proj + (size_t)(t0 + g8 + k) * INW + 2304 + c4);
      { const int t = t0 + g8; bool first; if (t < T_P) first = (t & 2047) == 0; else first = ((t - T_P) & 7) == 0;
        if (!first) row[0] = ld4(proj + (size_t)(t - 1) * INW + 2304 + c4);
        else if (t < T_P) { row[0].x = 0.f; row[0].y = 0.f; row[0].z = 0.f; row[0].w = 0.f; }
        else row[0] = *(const float4*)(p->in[I_SSHIFT] + ((size_t)l * 128 + ((t - T_P) >> 3)) * 1024 + c4); }
#pragma unroll
      for (int k = 0; k < 8; ++k) { const int i = g8 + k, t = t0 + i; const float4 cur = row[k + 1]; float4 prev = row[k];
        bool last; if (t < T_P) last = (t & 2047) == 2047; else last = ((t - T_P) & 7) == 7;
        float4 o; o.x = cur.x + (prev.x - cur.x) * m.x; o.y = cur.y + (prev.y - cur.y) * m.y; o.z = cur.z + (prev.z - cur.z) * m.z; o.w = cur.w + (prev.w - cur.w) * m.w;
        *(float4*)(pm + i * 1024 + c4) = o;
        if (c4 >= 768) { float4 a_; const int j = c4 - 768;
          if (j < 64) { a_.x = tanh_(o.x); a_.y = tanh_(o.y); a_.z = tanh_(o.z); a_.w = tanh_(o.w); } else if (j < 128) a_ = o; else { a_.x = sigm(o.x); a_.y = sigm(o.y); a_.z = sigm(o.z); a_.w = sigm(o.w); }
          u32x2 wv_; wv_.x = pack2(a_.x, a_.y); wv_.y = pack2(a_.z, a_.w); *(u32x2*)(actb + i * 264 + j) = wv_; }
        if (last) { float* dst = t < T_P ? p->out + O_PSH + ((size_t)l * 8 + (t >> 11)) * 1024 + c4 : p->out + O_SSH + ((size_t)l * 128 + ((t - T_P) >> 3)) * 1024 + c4; *(float4*)dst = cur; }
      }
    }
    __syncthreads();
    f32x4 accw[2], acca[2], accg[2];
#pragma unroll
    for (int nt = 0; nt < 2; ++nt) { accw[nt] = (f32x4){0.f, 0.f, 0.f, 0.f}; acca[nt] = accw[nt]; accg[nt] = accw[nt]; }
#pragma unroll
    for (int ks = 0; ks < 8; ++ks) { const bf16x8 a = *(const bf16x8*)(actb + fr * 264 + ks * 32 + kg * 8);
#pragma unroll
      for (int nt = 0; nt < 2; ++nt) {
        if (ks < 2) accw[nt] = __builtin_amdgcn_mfma_f32_16x16x32_bf16(a, bw[nt][ks], accw[nt], 0, 0, 0);
        else if (ks < 4) acca[nt] = __builtin_amdgcn_mfma_f32_16x16x32_bf16(a, bw[nt][ks], acca[nt], 0, 0, 0);
        else accg[nt] = __builtin_amdgcn_mfma_f32_16x16x32_bf16(a, bw[nt][ks], accg[nt], 0, 0, 0); } }
    float kv[4][2];
#pragma unroll
    for (int j = 0; j < 4; ++j) { const int tk = kg * 4 + j; float sq = 0.f;
#pragma unroll
      for (int nt = 0; nt < 2; ++nt) { const float k = pm[tk * 1024 + 256 + w * 32 + nt * 16 + fr]; kv[j][nt] = k; const float kkv = k * kkc[nt]; sq += kkv * kkv; }
      sq = row_sum16(sq); if (fr == 0) part[tk * 8 + w] = sq; }
    __syncthreads();
#pragma unroll
    for (int j = 0; j < 4; ++j) { const int tk = kg * 4 + j, t = t0 + tk;
      const float n2 = part[tk * 8 + (w & 6)] + part[tk * 8 + (w | 1)]; const float inv = 1.0f / fmaxf(sqrtf(n2), 1e-12f);
#pragma unroll
      for (int nt = 0; nt < 2; ++nt) { const int c = w * 32 + nt * 16 + fr, cc = c & 63;
        const float wv = w0[nt] + accw[nt][j]; const float decay = __expf(-0.6065306597126334f * sigm(wv)); const float iclr = sigm(a0[nt] + acca[nt][j]);
        const float k = kv[j][nt]; const float kkn = k * kkc[nt] * inv; const float k2 = k * (1.0f + (iclr - 1.0f) * kac[nt]);
        const float r = pm[tk * 1024 + c], v = pm[tk * 1024 + 512 + c];
        float* rp = rec + ((size_t)head * T_ALL + t) * 384 + cc;
        rp[0] = decay; rp[64] = kkn; rp[128] = kkn * iclr; rp[192] = k2; rp[256] = r; rp[320] = v;
        gate[(size_t)t * 256 + c] = accg[nt][j]; } }
    __syncthreads();
  }
}

__device__ __forceinline__ bf16x8 make_cf(const float* src, float sg) {
  const float4 a = *(const float4*)src, b = *(const float4*)(src + 4);
  u32x4 cw; cw.x = pack2(sg * a.x, sg * a.y); cw.y = pack2(sg * a.z, sg * a.w); cw.z = pack2(sg * b.x, sg * b.y); cw.w = pack2(sg * b.z, sg * b.w);
  bf16x8 r; __builtin_memcpy(&r, &cw, 16); return r;
}
template <bool FULL>
__device__ void s5_units(KP p, const Ctx cx, int l, unsigned char* ldsraw) {
  const int tid = cx.tid, w = tid >> 6, lane = tid & 63, fr = lane & 15, kg = lane >> 4;
  float* ubuf = (float*)(ldsraw + w * 8704);
  bf16_t* Ht = (bf16_t*)(ldsraw + w * 8704 + 4096);
  const float* cst = (const float*)(p->ws + WS_S5C) + (size_t)l * 36864;
  const bf16_t* proj = (const bf16_t*)(p->ws + WS_PROJ); float* E = (float*)(p->ws + WS_S5E);
  float* ysf = (float*)(p->ws + WS_YSF); bf16_t* ysb = (bf16_t*)(p->ws + WS_YSB);
  const int nunits = FULL ? 4096 + 2048 : 4096, gw = cx.bid * 8 + w, nw = cx.G * 8;
  for (int unit = gw; unit < nunits; unit += nw) {
    const bool sample = unit >= 4096;
    int seq, g, c, tok0, nsteps;
    if (!sample) { seq = unit >> 9; g = (unit >> 5) & 15; c = unit & 31; tok0 = seq * 2048 + c * 64; nsteps = 64; }
    else { const int u2 = unit - 4096; seq = u2 >> 4; g = u2 & 15; c = 0; tok0 = T_P + seq * 8; nsteps = 8; }
    for (int idx = lane; idx < nsteps * 4; idx += 64) { const int s = idx >> 2, q = idx & 3; *(float4*)(ubuf + s * 16 + q * 4) = ld4(proj + (size_t)(tok0 + s) * INW + g * 16 + q * 4); }
    const int gp = g * 64 + lane;
    float bre[16], bim[16];
#pragma unroll
    for (int q = 0; q < 4; ++q) { const float4 a = *(const float4*)(cst + 4096 + gp * 16 + q * 4), b = *(const float4*)(cst + 4096 + 16384 + gp * 16 + q * 4);
      bre[q * 4] = a.x; bre[q * 4 + 1] = a.y; bre[q * 4 + 2] = a.z; bre[q * 4 + 3] = a.w; bim[q * 4] = b.x; bim[q * 4 + 1] = b.y; bim[q * 4 + 2] = b.z; bim[q * 4 + 3] = b.w; }
    const float lre = cst[gp], lim = cst[1024 + gp];
    float hre = 0.f, him = 0.f;
    if (FULL) {
      if (sample) { hre = p->in[I_S5RE][((size_t)l * 128 + seq) * 1024 + gp]; him = p->in[I_S5IM][((size_t)l * 128 + seq) * 1024 + gp]; }
      else { const float qre = cst[2048 + gp], qim = cst[3072 + gp];
#pragma unroll 4
        for (int j = 0; j < c; ++j) { const float ere = E[((size_t)((seq * 16 + g) * 32 + j) * 2 + 0) * 64 + lane], eim = E[((size_t)((seq * 16 + g) * 32 + j) * 2 + 1) * 64 + lane];
          const float nr = qre * hre - qim * him + ere, ni = qre * him + qim * hre + eim; hre = nr; him = ni; } }
    }
    bf16x8 cf0 = {0, 0, 0, 0, 0, 0, 0, 0}, cf1 = cf0, cf2 = cf0, cf3 = cf0; float dsk = 0.f;
    if (FULL) {
      const float* cre = p->in[I_CRE] + ((size_t)(l * 16 + g) * 16 + fr) * 64 + kg * 8; const float* cim = p->in[I_CIM] + ((size_t)(l * 16 + g) * 16 + fr) * 64 + kg * 8;
      cf0 = make_cf(cre, 1.f); cf1 = make_cf(cre + 32, 1.f); cf2 = make_cf(cim, -1.f); cf3 = make_cf(cim + 32, -1.f);
      dsk = p->in[I_S5D][(l * 16 + g) * 16 + fr];
    }
    for (int tile = 0; tile * 16 < nsteps; ++tile) {
#pragma unroll 4
      for (int s = 0; s < 16; ++s) {
        const int st = tile * 16 + s;
        if (st < nsteps) {
          float br4[4], bi4[4];
#pragma unroll
          for (int q = 0; q < 4; ++q) { const float4 u = *(const float4*)(ubuf + st * 16 + q * 4);
            br4[q] = (bre[q * 4] * u.x + bre[q * 4 + 1] * u.y) + (bre[q * 4 + 2] * u.z + bre[q * 4 + 3] * u.w);
            bi4[q] = (bim[q * 4] * u.x + bim[q * 4 + 1] * u.y) + (bim[q * 4 + 2] * u.z + bim[q * 4 + 3] * u.w); }
          const float bur = (br4[0] + br4[1]) + (br4[2] + br4[3]), bui = (bi4[0] + bi4[1]) + (bi4[2] + bi4[3]);
          const float nr = lre * hre - lim * him + bur, ni = lre * him + lim * hre + bui; hre = nr; him = ni;
        }
        if (FULL) { Ht[s * 136 + lane] = f2bf(hre); Ht[s * 136 + 64 + lane] = f2bf(him); }
      }
      if (FULL) {
        f32x4 acc = {0.f, 0.f, 0.f, 0.f};
        { const bf16_t* hp = Ht + fr * 136 + kg * 8;
          acc = __builtin_amdgcn_mfma_f32_16x16x32_bf16(*(const bf16x8*)(hp), cf0, acc, 0, 0, 0); acc = __builtin_amdgcn_mfma_f32_16x16x32_bf16(*(const bf16x8*)(hp + 32), cf1, acc, 0, 0, 0);
          acc = __builtin_amdgcn_mfma_f32_16x16x32_bf16(*(const bf16x8*)(hp + 64), cf2, acc, 0, 0, 0); acc = __builtin_amdgcn_mfma_f32_16x16x32_bf16(*(const bf16x8*)(hp + 96), cf3, acc, 0, 0, 0); }
#pragma unroll
        for (int j = 0; j < 4; ++j) { const int tt = tile * 16 + kg * 4 + j;
          if (tt < nsteps) { const float uval = ubuf[tt * 16 + fr]; float y = acc[j] + dsk * uval;
            const float in = 0.7978845608028654f * (y + 0.044715f * y * y * y); y = 0.5f * y * (1.0f + tanh_(in));
            const size_t o = (size_t)(tok0 + tt) * 256 + g * 16 + fr; ysf[o] = y; ysb[o] = f2bf(y); } }
      }
    }
    if (!FULL) { E[((size_t)((seq * 16 + g) * 32 + c) * 2 + 0) * 64 + lane] = hre; E[((size_t)((seq * 16 + g) * 32 + c) * 2 + 1) * 64 + lane] = him; }
    else if (sample) { p->out[O_SRE + ((size_t)l * 128 + seq) * 1024 + gp] = hre; p->out[O_SIM + ((size_t)l * 128 + seq) * 1024 + gp] = him; }
    else if (c == 31) { p->out[O_PRE + ((size_t)l * 8 + seq) * 1024 + gp] = hre; p->out[O_PIM + ((size_t)l * 8 + seq) * 1024 + gp] = him; }
  }
}

constexpr int RW_STG = 6144, HB_BASE = 3 * 6144, HB_STG = 7168, OFF_HG = 0, OFF_RT = 4096;
#define DPPF(x, ctrl) __int_as_float(__builtin_amdgcn_update_dpp(0, __float_as_int(x), (ctrl), 0xf, 0xf, false))
__device__ __forceinline__ float sum8(float x) { x += DPPF(x, 0x141); x += DPPF(x, 0xB1); x += DPPF(x, 0x4E); return x; }
struct RwOp { f32x4 w, kk, ka, kv, rr; float vr; };
struct HgOp { f32x4 f0, f1, q0, q1; float vr; };
struct RtOp { f32x4 k0, k1, q0, q1; float vr; };
__device__ __forceinline__ void rw_load(RwOp& o, const float* buf, int i, int k4, int row) { const float* b = buf + i * 384;
  o.w = *(const f32x4*)(b + k4); o.kk = *(const f32x4*)(b + 64 + k4); o.ka = *(const f32x4*)(b + 128 + k4); o.kv = *(const f32x4*)(b + 192 + k4); o.rr = *(const f32x4*)(b + 256 + k4); o.vr = b[320 + row]; }
__device__ __forceinline__ float rw_step(const RwOp& o, f32x2& sA, f32x2& sB) {
  const f32x2 p = sA * o.kk.lo + sB * o.kk.hi;
  const float sa = -row_sum16(p.x + p.y);
  const f32x2 tA = o.kv.lo * o.vr + o.ka.lo * sa, tB = o.kv.hi * o.vr + o.ka.hi * sa;
  sA = sA * o.w.lo + tA; sB = sB * o.w.hi + tB;
  const f32x2 q = sA * o.rr.lo + sB * o.rr.hi;
  return row_sum16(q.x + q.y); }
__device__ __forceinline__ void hg_load(HgOp& o, const float* buf, int i, int k8, int row) { const float* b = buf + OFF_HG + i * 64;
  o.f0 = *(const f32x4*)(b + k8); o.f1 = *(const f32x4*)(b + k8 + 4); o.q0 = *(const f32x4*)(b + 2048 + k8); o.q1 = *(const f32x4*)(b + 2048 + k8 + 4); o.vr = b[3072 + row]; }
__device__ __forceinline__ float hg_step(const HgOp& o, f32x2 (&s)[4]) {
  const float v = o.vr;
  s[0] = (s[0] - v) * o.f0.lo + v; s[1] = (s[1] - v) * o.f0.hi + v; s[2] = (s[2] - v) * o.f1.lo + v; s[3] = (s[3] - v) * o.f1.hi + v;
  const f32x2 q = (s[0] * o.q0.lo + s[1] * o.q0.hi) + (s[2] * o.q1.lo + s[3] * o.q1.hi);
  return sum8(q.x + q.y); }
__device__ __forceinline__ void rt_load(RtOp& o, const float* buf, int i, int k8, int row) { const float* b = buf + OFF_RT + i * 64;
  o.k0 = *(const f32x4*)(b + k8); o.k1 = *(const f32x4*)(b + k8 + 4); o.q0 = *(const f32x4*)(b + 1024 + k8); o.q1 = *(const f32x4*)(b + 1024 + k8 + 4); o.vr = b[2048 + row]; }
__device__ __forceinline__ float rt_step(const RtOp& o, f32x2 (&s)[4], float gam) {
  const float v = o.vr;
  s[0] = s[0] * gam + o.k0.lo * v; s[1] = s[1] * gam + o.k0.hi * v; s[2] = s[2] * gam + o.k1.lo * v; s[3] = s[3] * gam + o.k1.hi * v;
  const f32x2 q = (s[0] * o.q0.lo + s[1] * o.q0.hi) + (s[2] * o.q1.lo + s[3] * o.q1.hi);
  return sum8(q.x + q.y); }

struct LdRegs { u32x2 hq, hf, hv, x1, x2, rv; float4 cs, sn; };
__device__ __forceinline__ void ld_dma(LAS unsigned char* gl, int wv, int nx, int bseq, int head, int lt, const float* rec) {
  const int tbn = nx < 128 ? bseq * 2048 + nx * 16 : T_P + (bseq * 16 + (nx - 128) * 2) * 8;
  const float* rb = rec + ((size_t)head * T_ALL + tbn) * 384 + wv * 256; LAS unsigned char* dst = gl + (nx % 3) * (6144 * 4) + wv * 1024; const unsigned lo = (unsigned)(lt & 63) * 4u;
#pragma unroll
  for (int n = 0; n < 6; ++n) __builtin_amdgcn_global_load_lds((const unsigned*)(rb + n * 1024 + lo), (LAS unsigned*)(dst + n * 4096), 16, 0, 0);
  asm volatile("" ::: "memory");
}
__device__ __forceinline__ void ld_loads(LdRegs& R, int nx, int bseq, int head, int hi, int hc4, int arr, int ri, int rc4, const bf16_t* proj, const float* rope) {
  const int tbn = nx < 128 ? bseq * 2048 + nx * 16 : T_P + (bseq * 16 + (nx - 128) * 2) * 8;
  const bf16_t* pb = proj + (size_t)tbn * INW + head * 64;
  const unsigned oh = (unsigned)(hi * INW + 256 + hc4), orr = (unsigned)(ri * INW + 1280 + arr * 256 + rc4);
  R.hq = *(const u32x2*)(pb + oh); R.hf = *(const u32x2*)(pb + oh + 256); R.hv = *(const u32x2*)(pb + oh + 512);
  R.x1 = *(const u32x2*)(pb + orr); R.x2 = *(const u32x2*)(pb + orr + 32);
  R.rv = *(const u32x2*)(pb + oh + 1536);
  const float* rpb = rope + (nx < 128 ? nx * 1024 : 2048 * 64); const unsigned orp = (unsigned)((nx < 128 ? ri : (ri & 7)) * 64 + rc4);
  R.cs = *(const float4*)(rpb + orp); R.sn = *(const float4*)(rpb + orp + 32);
  asm volatile("" ::: "memory");
}
__device__ __forceinline__ void ld_commit(const LdRegs& R, float* nb, int lt, int hi, int hc4, int arr, int ri, int rc4, const float4 lb) {
  const float4 Rhq = cv4(R.hq), Rhf = cv4(R.hf), Rhv = cv4(R.hv), Rx1 = cv4(R.x1), Rx2 = cv4(R.x2), Rrv = cv4(R.rv);
  { float4 o; o.x = siluf(Rhq.x); o.y = siluf(Rhq.y); o.z = siluf(Rhq.z); o.w = siluf(Rhq.w); *(float4*)(nb + OFF_HG + 2048 + hi * 64 + hc4) = o; *(float4*)(nb + OFF_HG + 3072 + hi * 64 + hc4) = Rhv;
    float4 f, ky;
    f.x = lb.x + (1.f - lb.x) * sigm(Rhf.x); ky.x = (1.f - lb.x) * sigm(-Rhf.x); f.y = lb.y + (1.f - lb.y) * sigm(Rhf.y); ky.y = (1.f - lb.y) * sigm(-Rhf.y);
    f.z = lb.z + (1.f - lb.z) * sigm(Rhf.z); ky.z = (1.f - lb.z) * sigm(-Rhf.z); f.w = lb.w + (1.f - lb.w) * sigm(Rhf.w); ky.w = (1.f - lb.w) * sigm(-Rhf.w);
    *(float4*)(nb + OFF_HG + hi * 64 + hc4) = f; *(float4*)(nb + OFF_HG + 1024 + hi * 64 + hc4) = ky; }
  { const float sc = arr == 1 ? 0.125f : 1.0f; float4 o1, o2; const float4 x1 = Rx1, x2 = Rx2, cs = R.cs, sn = R.sn;
    o1.x = (x1.x * cs.x - x2.x * sn.x) * sc; o2.x = (x1.x * sn.x + x2.x * cs.x) * sc; o1.y = (x1.y * cs.y - x2.y * sn.y) * sc; o2.y = (x1.y * sn.y + x2.y * cs.y) * sc;
    o1.z = (x1.z * cs.z - x2.z * sn.z) * sc; o2.z = (x1.z * sn.z + x2.z * cs.z) * sc; o1.w = (x1.w * cs.w - x2.w * sn.w) * sc; o2.w = (x1.w * sn.w + x2.w * cs.w) * sc;
    float* d = nb + OFF_RT + (arr == 1 ? 0 : 1024) + ri * 64 + rc4; *(float4*)d = o1; *(float4*)(d + 32) = o2;
    *(float4*)(nb + OFF_RT + 2048 + hi * 64 + hc4) = Rrv; }
}

__device__ void recur_phase(KP p, const Ctx cx, int l, float* lds, LAS unsigned char* gl) {
  const int tid = cx.tid, w = __builtin_amdgcn_readfirstlane(tid >> 6), lane = tid & 63, wv = w & 3;
  const bf16_t* proj = (const bf16_t*)(p->ws + WS_PROJ); const float* rec = (const float*)(p->ws + WS_REC); float* oraw = (float*)(p->ws + WS_ORAW);
  const float* lbl = p->in[I_LBLOG]; const float* rope = (const float*)(p->ws + WS_ROPE);
  for (int unit0 = cx.bid; unit0 < 256; unit0 += cx.G) {
    int unit = unit0; if (cx.G == 256) { const int xcd = unit0 & 7, j = unit0 >> 3; unit = (((j >> 3) * 8 + xcd) << 3) | (j & 7); }
    const int bseq = unit >> 5, head = (unit >> 3) & 3, rs = unit & 7;
    const float gam = 1.0f - exp2f(-5.0f - (float)head);
    const int rrow = rs * 8 + (w & 1) * 4 + (lane >> 4), k4 = (lane & 15) * 4;
    const int hrow = rs * 8 + (lane >> 3), k8 = (lane & 7) * 8;
    f32x2 sA = {0.f, 0.f}, sB = {0.f, 0.f};
    f32x2 s8[4];
#pragma unroll
    for (int j = 0; j < 4; ++j) s8[j] = (f32x2){0.f, 0.f};
    const float* st_in = w == 2 ? p->in[I_SHG] : p->in[I_SRT];
    float* st_ps = p->out + (w == 2 ? O_PHG : O_PRT); float* st_ss = p->out + (w == 2 ? O_SHG : O_SRT);
    const int lt = tid - 256, hi = (lt >> 4) & 15, hc4 = (lt & 15) * 4, arr = (lt >> 7) & 1, ri = (lt & 127) >> 3, rc4 = (lt & 7) * 4;
    float4 lb; lb.x = 0.f; lb.y = 0.f; lb.z = 0.f; lb.w = 0.f;
    if (l > 0 && w >= 4) { const float4 la = *(const float4*)(lbl + head * 64 + hc4), lc = *(const float4*)(lbl + 256 + head * 64 + hc4);
      lb.x = 1.0f / (1.0f + __expf(la.x - lc.x)); lb.y = 1.0f / (1.0f + __expf(la.y - lc.y)); lb.z = 1.0f / (1.0f + __expf(la.z - lc.z)); lb.w = 1.0f / (1.0f + __expf(la.w - lc.w)); }
    if (w >= 4) ld_dma(gl, wv, 0, bseq, head, lt, rec);
    for (int it = -1; it < 136; ++it) {
     {
      if (w >= 4) {
        if (it + 1 < 136) { LdRegs L; ld_loads(L, it + 1, bseq, head, hi, hc4, arr, ri, rc4, proj, rope);
#ifdef LOADER_TWICE
          asm volatile("s_waitcnt vmcnt(0)" ::: "memory"); { LdRegs L2; ld_loads(L2, (it + 9) % 128, bseq, head, hi, hc4, arr, ri, rc4, proj, rope); asm volatile("s_waitcnt vmcnt(0)" ::: "memory"); asm volatile("" :: "v"(L2.hq.x), "v"(L2.x1.x), "v"(L2.rv.x), "v"(L2.cs.x)); }
#endif
          ld_commit(L, lds + HB_BASE + ((it + 1) & 1) * HB_STG, lt, hi, hc4, arr, ri, rc4, lb);
          asm volatile("" ::: "memory");
          if (it + 2 < 136) ld_dma(gl, wv, it + 2, bseq, head, lt, rec); }
      } else if (it >= 0 && it < 136) {
        const float* buf = lds + (it % 3) * RW_STG; const float* hbuf = lds + HB_BASE + (it & 1) * HB_STG;
        const int tb = it < 128 ? bseq * 2048 + it * 16 : T_P + (bseq * 16 + (it - 128) * 2) * 8;
        if (w < 2) {
          float yk = 0.f;
          float4 nsA, nsB; nsA.x = nsA.y = nsA.z = nsA.w = 0.f; nsB = nsA;
          if (it >= 128) { const float* sp = p->in[I_SRW] + ((size_t)(l * 128 + bseq * 16 + (it - 128) * 2) * 4 + head) * 4096 + rrow * 64 + k4;
            nsA = *(const float4*)sp; nsB = *(const float4*)(sp + 4 * 4096); }
          {
            RwOp A, B, C;
#define RW_L(P, i) rw_load(P, buf, (i), k4, rrow); __builtin_amdgcn_sched_barrier(0)
#define RW_S(P, i) { const float y = rw_step(P, sA, sB); yk = ((lane & 15) == (i)) ? y : yk; } __builtin_amdgcn_sched_barrier(0)
            if (it >= 128) { sA = (f32x2){nsA.x, nsA.y}; sB = (f32x2){nsA.z, nsA.w}; }
            RW_L(A, 0); RW_L(B, 1); RW_L(C, 2);
            RW_S(A, 0); RW_L(A, 3); RW_S(B, 1); RW_L(B, 4); RW_S(C, 2); RW_L(C, 5);
            RW_S(A, 3); RW_L(A, 6); RW_S(B, 4); RW_L(B, 7); RW_S(C, 5); RW_L(C, 8);
            RW_S(A, 6); RW_L(A, 9); RW_S(B, 7); RW_L(B, 10);
            if (it >= 128) {
              float* dp = p->out + O_SRW + ((size_t)(l * 128 + bseq * 16 + (it - 128) * 2) * 4 + head) * 4096;
              float4 v; v.x = sA.x; v.y = sA.y; v.z = sB.x; v.w = sB.y; *(float4*)(dp + rrow * 64 + k4) = v;
              sA = (f32x2){nsB.x, nsB.y}; sB = (f32x2){nsB.z, nsB.w}; }
            RW_S(C, 8); RW_L(C, 11);
            RW_S(A, 9); RW_L(A, 12); RW_S(B, 10); RW_L(B, 13); RW_S(C, 11); RW_L(C, 14);
            RW_S(A, 12); RW_L(A, 15); RW_S(B, 13); RW_S(C, 14); RW_S(A, 15);
#undef RW_L
#undef RW_S
            if (it >= 127) { float* dp = it >= 128 ? p->out + O_SRW + ((size_t)(l * 128 + bseq * 16 + (it - 128) * 2 + 1) * 4 + head) * 4096 : p->out + O_PRW + ((size_t)(l * 8 + bseq) * 4 + head) * 4096;
              float4 v; v.x = sA.x; v.y = sA.y; v.z = sB.x; v.w = sB.y; *(float4*)(dp + rrow * 64 + k4) = v; }
          }
          { float* ob_ = oraw + (size_t)tb * 768 + 512 + head * 64; ob_[(unsigned)((lane & 15) * 768 + rrow)] = yk; }
        } else {
          float yk0 = 0.f, yk1 = 0.f;
          float nA[8], nB[8];
#pragma unroll
          for (int j = 0; j < 8; ++j) { nA[j] = 0.f; nB[j] = 0.f; }
          if (it >= 128) { const float* sp = st_in + ((size_t)(l * 128 + bseq * 16 + (it - 128) * 2) * 4 + head) * 4096;
#pragma unroll
            for (int j = 0; j < 8; ++j) { nA[j] = sp[(k8 + j) * 64 + hrow]; nB[j] = sp[4 * 4096 + (k8 + j) * 64 + hrow]; } }
          {
#define HS_SEL(i, y) { const bool m_ = (lane & 7) == ((i) & 7); if ((i) < 8) yk0 = m_ ? (y) : yk0; else yk1 = m_ ? (y) : yk1; }
#define MID_SWAP() if (it >= 128) { float* dp = st_ss + ((size_t)(l * 128 + bseq * 16 + (it - 128) * 2) * 4 + head) * 4096; \
              _Pragma("unroll") for (int j = 0; j < 4; ++j) { dp[(k8 + 2 * j) * 64 + hrow] = s8[j].x; dp[(k8 + 2 * j + 1) * 64 + hrow] = s8[j].y; s8[j] = (f32x2){nB[2 * j], nB[2 * j + 1]}; } }
            if (it >= 128) {
#pragma unroll
              for (int j = 0; j < 4; ++j) s8[j] = (f32x2){nA[2 * j], nA[2 * j + 1]}; }
            if (w == 2) {
              HgOp A, B, C;
#define H_L(P, i) hg_load(P, hbuf, (i), k8, hrow); __builtin_amdgcn_sched_barrier(0)
#define H_S(P, i) { const float y = hg_step(P, s8); HS_SEL(i, y) } __builtin_amdgcn_sched_barrier(0)
              H_L(A, 0); H_L(B, 1); H_L(C, 2);
              H_S(A, 0); H_L(A, 3); H_S(B, 1); H_L(B, 4); H_S(C, 2); H_L(C, 5);
              H_S(A, 3); H_L(A, 6); H_S(B, 4); H_L(B, 7); H_S(C, 5); H_L(C, 8);
              H_S(A, 6); H_L(A, 9); H_S(B, 7); H_L(B, 10);
              MID_SWAP()
              H_S(C, 8); H_L(C, 11);
              H_S(A, 9); H_L(A, 12); H_S(B, 10); H_L(B, 13); H_S(C, 11); H_L(C, 14);
              H_S(A, 12); H_L(A, 15); H_S(B, 13); H_S(C, 14); H_S(A, 15);
#undef H_L
#undef H_S
            } else {
              RtOp A, B, C;
#define H_L(P, i) rt_load(P, hbuf, (i), k8, hrow); __builtin_amdgcn_sched_barrier(0)
#define H_S(P, i) { const float y = rt_step(P, s8, gam); HS_SEL(i, y) } __builtin_amdgcn_sched_barrier(0)
              H_L(A, 0); H_L(B, 1); H_L(C, 2);
              H_S(A, 0); H_L(A, 3); H_S(B, 1); H_L(B, 4); H_S(C, 2); H_L(C, 5);
              H_S(A, 3); H_L(A, 6); H_S(B, 4); H_L(B, 7); H_S(C, 5); H_L(C, 8);
              H_S(A, 6); H_L(A, 9); H_S(B, 7); H_L(B, 10);
              MID_SWAP()
              H_S(C, 8); H_L(C, 11);
              H_S(A, 9); H_L(A, 12); H_S(B, 10); H_L(B, 13); H_S(C, 11); H_L(C, 14);
              H_S(A, 12); H_L(A, 15); H_S(B, 13); H_S(C, 14); H_S(A, 15);
#undef H_L
#undef H_S
            }
#undef HS_SEL
#undef MID_SWAP
            if (it >= 127) { float* dp = it >= 128 ? st_ss + ((size_t)(l * 128 + bseq * 16 + (it - 128) * 2 + 1) * 4 + head) * 4096 : st_ps + ((size_t)(l * 8 + bseq) * 4 + head) * 4096;
#pragma unroll
              for (int j = 0; j < 4; ++j) { dp[(k8 + 2 * j) * 64 + hrow] = s8[j].x; dp[(k8 + 2 * j + 1) * 64 + hrow] = s8[j].y; } }
          }
          { float* ob_ = oraw + (size_t)tb * 768 + (w == 2 ? 0 : 256) + head * 64; const unsigned oo = (unsigned)((lane & 7) * 768 + hrow); ob_[oo] = yk0; ob_[oo + 8 * 768] = yk1; }
        }
      }
      asm volatile("s_waitcnt lgkmcnt(0)" ::: "memory"); __builtin_amdgcn_s_barrier(); asm volatile("" ::: "memory");
     }
    }
    __syncthreads();
  }
}

__device__ void mix_phase(KP p, const Ctx cx, int l) {
  const int lane = cx.tid & 63, gw = cx.bid * 8 + (cx.tid >> 6), nw = cx.G * 8, c = lane * 4, head = lane >> 4, cc = (lane & 15) * 4;
  const bf16_t* proj = (const bf16_t*)(p->ws + WS_PROJ); const float* rec = (const float*)(p->ws + WS_REC); const float* gate = (const float*)(p->ws + WS_GATE);
  const float* oraw = (const float*)(p->ws + WS_ORAW); const float* gluo = (const float*)(p->ws + WS_GLUO); bf16_t* mix = (bf16_t*)(p->ws + WS_MIX);
  const float* ysf = (const float*)(p->ws + WS_YSF); const float4 bgl = *(const float4*)(p->in[I_BGLU] + l * 256 + c);
  const float4 s5n = *(const float4*)(p->in[I_S5NORM] + l * 256 + c), hgn = *(const float4*)(p->in[I_HGNORM] + l * 256 + c);
  const float4 lng = *(const float4*)(p->in[I_RWLNG] + l * 256 + c), lnb = *(const float4*)(p->in[I_RWLNB] + l * 256 + c), rk = *(const float4*)(p->in[I_RWRK] + l * 256 + c);
  struct MixIn { float4 z, yv, oh, gph, ort, gpr, y, k2, rr, v, gt; };
#define MIX_LOAD(M, t_) { const int tt_ = (t_); M.z = *(const float4*)(gluo + (size_t)tt_ * 256 + c); M.yv = *(const float4*)(ysf + (size_t)tt_ * 256 + c); \
    M.oh = *(const float4*)(oraw + (size_t)tt_ * 768 + c); M.gph = ld4(proj + (size_t)tt_ * INW + 256 + 768 + c); \
    M.ort = *(const float4*)(oraw + (size_t)tt_ * 768 + 256 + c); M.gpr = ld4(proj + (size_t)tt_ * INW + 1280 + 768 + c); \
    M.y = *(const float4*)(oraw + (size_t)tt_ * 768 + 512 + c); const float* rp_ = rec + ((size_t)head * T_ALL + tt_) * 384 + cc; \
    M.k2 = *(const float4*)(rp_ + 192); M.rr = *(const float4*)(rp_ + 256); M.v = *(const float4*)(rp_ + 320); M.gt = *(const float4*)(gate + (size_t)tt_ * 256 + c); }
  MixIn cur; if (gw < T_ALL) MIX_LOAD(cur, gw)
  for (int t = gw; t < T_ALL; t += nw) {
    MixIn nxt = cur; const int tn = t + nw; if (tn < T_ALL) MIX_LOAD(nxt, tn)
    bf16_t* mrow = mix + (size_t)t * DM;
    const float4 z = cur.z, yv = cur.yv, oh = cur.oh, gph = cur.gph, ort = cur.ort, gpr = cur.gpr, y = cur.y, k2 = cur.k2, rr = cur.rr, v = cur.v, gt = cur.gt;
    { float4 g; g.x = yv.x * sigm(z.x + bgl.x); g.y = yv.y * sigm(z.y + bgl.y); g.z = yv.z * sigm(z.z + bgl.z); g.w = yv.w * sigm(z.w + bgl.w);
      const float ss = wave_sum(g.x * g.x + g.y * g.y + g.z * g.z + g.w * g.w, lane);
      const float r = rsqrtf(ss * (1.0f / 256.0f) + 1e-6f); u32x2 w; w.x = pack2(g.x * r * s5n.x, g.y * r * s5n.y); w.y = pack2(g.z * r * s5n.z, g.w * r * s5n.w); *(u32x2*)(mrow + c) = w; }
    { const float4 o = oh; const float hs = row_sum16(o.x * o.x + o.y * o.y + o.z * o.z + o.w * o.w);
      const float r = rsqrtf(hs * (1.0f / 64.0f) + 1e-6f); const float4 gp = gph;
      u32x2 w; w.x = pack2(o.x * r * hgn.x * siluf(gp.x), o.y * r * hgn.y * siluf(gp.y)); w.y = pack2(o.z * r * hgn.z * siluf(gp.z), o.w * r * hgn.w * siluf(gp.w)); *(u32x2*)(mrow + 256 + c) = w; }
    { const float4 o = ort; const float hs = row_sum16(o.x * o.x + o.y * o.y + o.z * o.z + o.w * o.w);
      const float r = rsqrtf(hs * (1.0f / 64.0f) + 1e-6f); const float4 gp = gpr;
      u32x2 w; w.x = pack2(o.x * r * siluf(gp.x), o.y * r * siluf(gp.y)); w.y = pack2(o.z * r * siluf(gp.z), o.w * r * siluf(gp.w)); *(u32x2*)(mrow + 512 + c) = w; }
    { const float mean = row_sum16(y.x + y.y + y.z + y.w) * (1.0f / 64.0f);
      const float dx = y.x - mean, dy = y.y - mean, dz = y.z - mean, dw = y.w - mean; const float var = row_sum16(dx * dx + dy * dy + dz * dz + dw * dw) * (1.0f / 64.0f);
      const float r = rsqrtf(var + 64e-5f);
      const float bonus = row_sum16(rr.x * k2.x * rk.x + rr.y * k2.y * rk.y + rr.z * k2.z * rk.z + rr.w * k2.w * rk.w);
      const float4 g = gt;
      u32x2 w; w.x = pack2((dx * r * lng.x + lnb.x + bonus * v.x) * g.x, (dy * r * lng.y + lnb.y + bonus * v.y) * g.y);
      w.y = pack2((dz * r * lng.z + lnb.z + bonus * v.z) * g.z, (dw * r * lng.w + lnb.w + bonus * v.w) * g.w); *(u32x2*)(mrow + 768 + c) = w; }
    cur = nxt;
  }
#undef MIX_LOAD
}

constexpr int KV_LD = 264;
__device__ __forceinline__ void load_kv_tile(const Ctx cx, const bf16_t* src, bf16_t* dst) {
  const int tid = cx.tid;
  u32x4 tv[16];
#pragma unroll
  for (int n = 0; n < 16; ++n) { const int idx = tid + n * 512, r = idx >> 5, c = (idx & 31) * 8; tv[n] = *(const u32x4*)(src + r * 256 + c); }
#pragma unroll
  for (int n = 0; n < 16; ++n) { const int idx = tid + n * 512, r = idx >> 5, c = (idx & 31) * 8; *(u32x4*)(dst + r * KV_LD + c) = tv[n]; }
}
__device__ void attn_prompt_unit(KP p, const Ctx cx, int l, int unit, unsigned char* ldsraw) {
  const int tid = cx.tid, w = tid >> 6, lane = tid & 63, fr = lane & 15, kg = lane >> 4;
  const int b = unit >> 6, head = (unit >> 4) & 3, qt = unit & 15;
  bf16_t* kv = (bf16_t*)ldsraw;
  const bf16_t* Kb = (const bf16_t*)(p->ws + WS_KB) + ((size_t)l * 32 + b * 4 + head) * 65536;
  const bf16_t* Vt = (const bf16_t*)(p->ws + WS_VT) + ((size_t)l * 32 + b * 4 + head) * 65536;
  const bf16_t* qb = (const bf16_t*)(p->ws + WS_QB); bf16_t* ob = (bf16_t*)(p->ws + WS_OB);
  const int tq = b * 2048 + qt * 128 + w * 16 + fr;
  load_kv_tile(cx, Kb, kv);
  bf16x8 qf[8];
#pragma unroll
  for (int ks = 0; ks < 8; ++ks) qf[ks] = *(const bf16x8*)(qb + (size_t)tq * DM + head * 256 + ks * 32 + kg * 8);
  __syncthreads();
  f32x4 sacc[16];
#pragma unroll
  for (int nt = 0; nt < 16; ++nt) { f32x4 a = {0.f, 0.f, 0.f, 0.f};
#pragma unroll
    for (int ks = 0; ks < 8; ++ks) { const bf16x8 kf = *(const bf16x8*)(kv + (nt * 16 + fr) * KV_LD + ks * 32 + kg * 8); a = __builtin_amdgcn_mfma_f32_16x16x32_bf16(kf, qf[ks], a, 0, 0, 0); }
    sacc[nt] = a; }
  float mx = -3.0e38f;
#pragma unroll
  for (int nt = 0; nt < 16; ++nt) mx = fmaxf(mx, fmaxf(fmaxf(sacc[nt][0], sacc[nt][1]), fmaxf(sacc[nt][2], sacc[nt][3])));
  mx = fmaxf(mx, shx(mx, 16, lane)); mx = fmaxf(mx, shx(mx, 32, lane));
  float sum = 0.f; bf16x8 pf[8];
#pragma unroll
  for (int k2 = 0; k2 < 8; ++k2) {
    float e[8];
#pragma unroll
    for (int j = 0; j < 4; ++j) { e[j] = __expf((sacc[2 * k2][j] - mx) * 0.0625f); e[4 + j] = __expf((sacc[2 * k2 + 1][j] - mx) * 0.0625f); }
#pragma unroll
    for (int j = 0; j < 8; ++j) { sum += e[j]; pf[k2][j] = (short)f2bf(e[j]); }
  }
  sum += shx(sum, 16, lane); sum += shx(sum, 32, lane);
  const float inv = 1.0f / sum;
  __syncthreads();
  load_kv_tile(cx, Vt, kv);
  __syncthreads();
#pragma unroll 1
  for (int dt = 0; dt < 16; ++dt) { f32x4 a = {0.f, 0.f, 0.f, 0.f};
#pragma unroll
    for (int k2 = 0; k2 < 8; ++k2) { const bf16_t* vp = kv + (dt * 16 + fr) * KV_LD + k2 * 32 + kg * 4;
      const u32x2 lo = *(const u32x2*)vp, hi = *(const u32x2*)(vp + 16); u32x4 vv; vv.x = lo.x; vv.y = lo.y; vv.z = hi.x; vv.w = hi.y;
      bf16x8 vf; __builtin_memcpy(&vf, &vv, 16);
      a = __builtin_amdgcn_mfma_f32_16x16x32_bf16(vf, pf[k2], a, 0, 0, 0); }
    u32x2 wv; wv.x = pack2(a[0] * inv, a[1] * inv); wv.y = pack2(a[2] * inv, a[3] * inv);
    *(u32x2*)(ob + (size_t)tq * DM + head * 256 + dt * 16 + kg * 4) = wv; }
  __syncthreads();
}

__device__ void attn_sample_unit(KP p, const Ctx cx, int l, int unit, unsigned char* ldsraw) {
  const int tid = cx.tid, w = tid >> 6, lane = tid & 63;
  const int b = unit >> 2, head = unit & 3;
  float* qs = (float*)ldsraw;
  float* S = qs + 2048;
  float* Pt = S + 2048;
  float* red = Pt + 2048;
  const bf16_t* qb = (const bf16_t*)(p->ws + WS_QB); bf16_t* ob = (bf16_t*)(p->ws + WS_OB);
  const float* Kc = p->in[I_CK] + ((size_t)(l * 128 + b) * 256) * 1024 + head * 256;
  const float* Vc = p->in[I_CV] + ((size_t)(l * 128 + b) * 256) * 1024 + head * 256;
  const int t0 = T_P + b * 8;
  { const float* qp = (const float*)(p->ws + WS_PART) + (size_t)(b * 8) * DM + head * 256;
    for (int idx = tid; idx < 2048; idx += NTHR) { const size_t o = (size_t)(idx >> 8) * DM + (idx & 255);
      qs[idx] = (qp[o] + qp[o + (size_t)T_S * DM]) + (qp[o + (size_t)2 * T_S * DM] + qp[o + (size_t)3 * T_S * DM]); } }
  __syncthreads();
  float4 q[8];
#pragma unroll
  for (int i = 0; i < 8; ++i) q[i] = *(const float4*)(qs + i * 256 + lane * 4);
#pragma unroll 1
  for (int kb2 = 0; kb2 < 2; ++kb2) {
   f32x4 kx[16];
#pragma unroll
   for (int kk = 0; kk < 16; ++kk) kx[kk] = __builtin_nontemporal_load((const f32x4*)(Kc + (size_t)(w * 32 + kb2 * 16 + kk) * 1024 + lane * 4));
#pragma unroll
   for (int kh = 0; kh < 2; ++kh) {
    const int kb = kb2 * 2 + kh;
    float v[64];
#pragma unroll
    for (int kk = 0; kk < 8; ++kk) {
#pragma unroll
      for (int i = 0; i < 8; ++i) v[kk * 8 + i] = kx[kh * 8 + kk].x * q[i].x + kx[kh * 8 + kk].y * q[i].y + kx[kh * 8 + kk].z * q[i].z + kx[kh * 8 + kk].w * q[i].w; }
#pragma unroll
    for (int off = 32; off >= 1; off >>= 1) { const bool up = (lane & off) != 0;
#pragma unroll
      for (int i = 0; i < off; ++i) { const float send = up ? v[i] : v[i + off]; const float keep = up ? v[i + off] : v[i]; v[i] = keep + shx(send, off, lane); } }
    S[(lane & 7) * 256 + w * 32 + kb * 8 + (lane >> 3)] = v[0];
   }
  }
  __syncthreads();
  { const float4 s = *(const float4*)(S + w * 256 + lane * 4); const float mx = wave_max(fmaxf(fmaxf(s.x, s.y), fmaxf(s.z, s.w)), lane);
    const float e0 = __expf((s.x - mx) * 0.0625f), e1 = __expf((s.y - mx) * 0.0625f), e2 = __expf((s.z - mx) * 0.0625f), e3 = __expf((s.w - mx) * 0.0625f);
    const float inv = 1.0f / wave_sum(e0 + e1 + e2 + e3, lane);
    Pt[(lane * 4 + 0) * 8 + w] = e0 * inv; Pt[(lane * 4 + 1) * 8 + w] = e1 * inv; Pt[(lane * 4 + 2) * 8 + w] = e2 * inv; Pt[(lane * 4 + 3) * 8 + w] = e3 * inv; }
  __syncthreads();
  float4 acc[8];
#pragma unroll
  for (int i = 0; i < 8; ++i) { acc[i].x = 0.f; acc[i].y = 0.f; acc[i].z = 0.f; acc[i].w = 0.f; }
#pragma unroll 16
  for (int kk = 0; kk < 32; ++kk) { const int m = w * 32 + kk; const f32x4 vx = __builtin_nontemporal_load((const f32x4*)(Vc + (size_t)m * 1024 + lane * 4));
    const float4 p0 = *(const float4*)(Pt + m * 8), p1 = *(const float4*)(Pt + m * 8 + 4); const float pr[8] = {p0.x, p0.y, p0.z, p0.w, p1.x, p1.y, p1.z, p1.w};
#pragma unroll
    for (int i = 0; i < 8; ++i) { acc[i].x += pr[i] * vx.x; acc[i].y += pr[i] * vx.y; acc[i].z += pr[i] * vx.z; acc[i].w += pr[i] * vx.w; } }
#pragma unroll
  for (int i = 0; i < 8; ++i) *(float4*)(red + (w * 8 + i) * 256 + lane * 4) = acc[i];
  __syncthreads();
  { const int i = tid >> 6; float4 s; s.x = 0.f; s.y = 0.f; s.z = 0.f; s.w = 0.f;
#pragma unroll
    for (int ww = 0; ww < 8; ++ww) { const float4 r = *(const float4*)(red + (ww * 8 + i) * 256 + lane * 4); s.x += r.x; s.y += r.y; s.z += r.z; s.w += r.w; }
    u32x2 o; o.x = pack2(s.x, s.y); o.y = pack2(s.z, s.w); *(u32x2*)(ob + (size_t)(t0 + i) * DM + head * 256 + lane * 4) = o; }
  __syncthreads();
}


#define XB_TMO      128
#define XB_XCNT(j)  (256  + 64 * (j))
#define XB_XSUB(j)  (1280 + 64 * (j))
#define XB_XGEN(j)  (2304 + 64 * (j))
#define XB_TOP      3328
#define XB_TOPGEN   3392
#define XCD_BAR_WORDS 3456
#define XB_SPIN_CAP (1u << 18)

__device__ __forceinline__ unsigned xb_ld(unsigned* p)              { return __hip_atomic_load(p, __ATOMIC_RELAXED, __HIP_MEMORY_SCOPE_AGENT); }
__device__ __forceinline__ unsigned xb_add(unsigned* p, unsigned v) { return __hip_atomic_fetch_add(p, v, __ATOMIC_RELAXED, __HIP_MEMORY_SCOPE_AGENT); }
__device__ __forceinline__ unsigned xb_xcc_id() { return (unsigned)__builtin_amdgcn_s_getreg((3 << 11) | 20) & 0xFu; }
#define XB_SPIN(cond, bar) do { unsigned _sp = 0; while (cond) { __builtin_amdgcn_s_sleep(1); \
    if ((++_sp & 255u) == 0u) { if (xb_ld(&(bar)[XB_TMO])) break; if (_sp > XB_SPIN_CAP) { atomicAdd(&(bar)[XB_TMO], 1u); break; } } } } while (0)
struct XcdBarrier {
    unsigned* bar; unsigned x;
    volatile LAS unsigned* st;
};

__device__ __forceinline__ XcdBarrier xcd_barrier_post(unsigned* bar, volatile LAS unsigned* st, int tid) {
    XcdBarrier b; b.bar = bar; b.x = xb_xcc_id(); b.st = st;
    if (tid == 0) (void)xb_add(&bar[XB_XCNT(b.x)], 1u);
    return b;
}
__device__ __forceinline__ void xcd_barrier_complete(unsigned* bar, unsigned x, unsigned& nloc, unsigned& nx) {
    const unsigned G = gridDim.x * gridDim.y * gridDim.z;
    unsigned sum, cnt, mine, sp = 0u;
    for (;;) {
        sum = 0u; cnt = 0u; mine = 0u;
#pragma unroll
        for (unsigned j = 0; j < 16; ++j) { const unsigned c = xb_ld(&bar[XB_XCNT(j)]); sum += c; cnt += (c > 0u) ? 1u : 0u; mine = (j == x) ? c : mine; }
        if (sum == G) break;
        __builtin_amdgcn_s_sleep(1);
        if ((++sp & 255u) == 0u) { if (xb_ld(&bar[XB_TMO])) break; if (sp > XB_SPIN_CAP) { atomicAdd(&bar[XB_TMO], 1u); break; } }
    }
    nloc = mine > 0u ? mine : 1u; nx = cnt > 0u ? cnt : 1u;
}

__device__ __forceinline__ void xcd_barrier(const XcdBarrier& b, int tid) {
    asm volatile("s_waitcnt vmcnt(0)" ::: "memory");
    __syncthreads();
    if (tid == 0) {
        unsigned* bar = b.bar;
        __builtin_amdgcn_s_waitcnt(0);
        unsigned nloc = b.st[0], nx = b.st[1];
        if (nloc == 0u) { xcd_barrier_complete(bar, b.x, nloc, nx); b.st[0] = nloc; b.st[1] = nx; }
        const unsigned old = xb_add(&bar[XB_XSUB(b.x)], 1u);
        const unsigned gen = old / nloc;
        if (old + 1u == (gen + 1u) * nloc) {
            __builtin_amdgcn_fence(__ATOMIC_RELEASE, "agent");
            asm volatile("s_waitcnt vmcnt(0)" ::: "memory");
            const unsigned og = xb_add(&bar[XB_TOP], 1u);
            const unsigned tg = og / nx;
            if (og + 1u == (tg + 1u) * nx) xb_add(&bar[XB_TOPGEN], 1u);
            else XB_SPIN(xb_ld(&bar[XB_TOPGEN]) == tg, bar);
            __builtin_amdgcn_fence(__ATOMIC_ACQUIRE, "agent");
            xb_add(&bar[XB_XGEN(b.x)], 1u);
            asm volatile("s_waitcnt vmcnt(0)" ::: "memory");
        } else {
            XB_SPIN(xb_ld(&bar[XB_XGEN(b.x)]) == gen, bar);
            __builtin_amdgcn_fence(__ATOMIC_ACQUIRE, "agent");
            asm volatile("s_waitcnt vmcnt(0)" ::: "memory");
        }
    }
    __syncthreads();
}


#ifndef REPEAT_S
#define REPEAT_S -1
#endif
constexpr int NPHASE = REPEAT_S >= 0 ? 31 : 29;
__global__ void __launch_bounds__(512) mega(Params p_) {
  extern __shared__ __attribute__((aligned(16))) unsigned char lds[];
  cg::grid_group grid = cg::this_grid();
  LAS unsigned char* gl = (LAS unsigned char*)lds;
  const int ph_lo = p_.ph_lo, ph_hi = p_.ph_hi;
  const int wid0 = __builtin_amdgcn_readfirstlane((int)threadIdx.x >> 6);
#ifndef PH_MASK
#define PH_MASK 0xFFFF
#endif
#define PHON(x) ((PH_MASK >> (x)) & 1)
#define MK_CTX() Ctx cx; { int ln_; asm volatile("v_mbcnt_lo_u32_b32 %0, -1, 0\n\tv_mbcnt_hi_u32_b32 %0, -1, %0" : "=v"(ln_)); cx.tid = wid0 * 64 + ln_; } cx.bid = blockIdx.x; cx.G = gridDim.x; asm volatile("" : "+s"(cx.bid), "+s"(cx.G));
  volatile LAS unsigned* xst = (volatile LAS unsigned*)(gl + LDS_MAIN);
  if (threadIdx.x == 0) { xst[0] = 0u; xst[1] = 0u; }
  __syncthreads();
  XcdBarrier xb = xcd_barrier_post((unsigned*)(p_.ws + WS_BAR), xst, (int)threadIdx.x);
  int ph = ph_lo;
  if (ph == 0) {
    KP p = get_params(); MK_CTX();
    if (PHON(14)) phase_prep(p, cx, lds);
    ph = 1; if (ph < ph_hi) grid.sync();
  }
  for (; ph < ph_hi; ++ph) {
    KP p = get_params(); MK_CTX();
#ifndef REPEAT_S
#define REPEAT_S -1
#endif
#ifndef EXTRA_SYNC
#define EXTRA_SYNC 0
#endif
    {
#if REPEAT_S >= 0
      const int l = (ph - 1) / 15, k_ = (ph - 1) % 15, s = k_ <= REPEAT_S ? k_ : k_ - 1;
#else
      const int l = (ph - 1) / 14, s = (ph - 1) % 14;
#endif
      unsigned char* wl = p->ws + WS_WT + (size_t)l * WL_SIZE;
      bf16_t* hA = (bf16_t*)(p->ws + WS_HA); float* xres = (float*)(p->ws + WS_XRES);
      if (s == 0 && PHON(0)) {
        { EpiBf<0> E{(bf16_t*)(p->ws + WS_PROJ), INW}; run_gemm(cx, gl, hA, (const bf16_t*)(wl + WL_IN), T_ALL, INW, DM, E, cx.bid); }
        const bf16_t* memb = (const bf16_t*)(p->ws + WS_MEMB);
        { EpiMemK E{p->out + O_PMK + (size_t)l * 2097152, (bf16_t*)(p->ws + WS_KB) + (size_t)l * 32 * 65536}; run_gemm(cx, gl, memb, (const bf16_t*)(wl + WL_K), 2048, DM, DM, E, (cx.bid + cx.G - 128 % cx.G) % cx.G); }
        { EpiStoreF32 E{p->out + O_PMV + (size_t)l * 2097152, DM}; run_gemm(cx, gl, memb, (const bf16_t*)(wl + WL_V), 2048, DM, DM, E, (cx.bid + cx.G - 160 % cx.G) % cx.G); }
        { EpiVt E{(bf16_t*)(p->ws + WS_VT) + (size_t)l * 32 * 65536}; run_gemm(cx, gl, (const bf16_t*)(wl + WL_V), memb, DM, 2048, DM, E, (cx.bid + cx.G - 192 % cx.G) % cx.G); }
      } else if (s == 1 && PHON(1)) {
        rwkv_prep(p, cx, l, lds);
        s5_units<false>(p, cx, l, lds);
      } else if (s == 2 && PHON(2)) {
#ifndef RECUR_REPS
#define RECUR_REPS 1
#endif
#ifndef S5B_REPS
#define S5B_REPS 1
#endif
        { int reps = RECUR_REPS; if (RECUR_REPS != 1) asm volatile("" : "+s"(reps));
#pragma unroll 1
          for (int r_ = 0; r_ < reps; ++r_) recur_phase(p, cx, l, (float*)lds, gl); }
        { int reps = S5B_REPS; if (S5B_REPS != 1) asm volatile("" : "+s"(reps));
#pragma unroll 1
          for (int r_ = 0; r_ < reps; ++r_) s5_units<true>(p, cx, l, lds); }
      } else if (s == 3 && PHON(3)) {
        EpiStoreF32 E{(float*)(p->ws + WS_GLUO), 256};
        run_gemm(cx, gl, (const bf16_t*)(p->ws + WS_YSB), (const bf16_t*)(wl + WL_GLU), T_ALL, 256, 256, E, cx.bid);
      } else if (s == 4 && PHON(4)) {
        mix_phase(p, cx, l);
      } else if ((s == 5 || s == 9 || s == 12) && PHON(5)) {
        const bf16_t* A = s == 5 ? (const bf16_t*)(p->ws + WS_MIX) : (s == 9 ? (const bf16_t*)(p->ws + WS_OB) : (const bf16_t*)(p->ws + WS_HID));
        const bf16_t* Bt = (const bf16_t*)(wl + (s == 5 ? WL_OUT : (s == 9 ? WL_O : WL_DOWN)));
        const int Kt = s == 12 ? DFF : DM;
        { EpiRes E{xres}; run_gemm(cx, gl, A, Bt, T_P, DM, Kt, E, cx.bid); }
        { const int nsl = s == 12 ? 16 : 4, Ks = Kt / nsl;
#pragma unroll 1
          for (int c = cx.bid; c < 16 * nsl; c += cx.G) {
            Ctx c2 = cx; asm volatile("" : "+v"(c2.tid));
            OneUnit S; S.valid = 1; const int un = c / nsl, sl = c % nsl; S.pm = un >> 2; S.pn = un & 3;
            pg8::Gemm g{A + (size_t)T_P * Kt + (size_t)sl * Ks, Bt + (size_t)sl * Ks, T_S, DM, Ks, Kt};
            EpiStoreF32 E{(float*)(p->ws + WS_PART) + (size_t)sl * T_S * DM, DM}; pg8::gemm_phase<EpiStoreF32, OneUnit>(gl, g, S, E, c2.tid); } }
      } else if ((s == 6 || s == 10) && PHON(6)) {
        rms_rows<false, false>(cx, xres, xres + (size_t)T_P * DM, (s == 6 ? p->in[I_NMEM] : p->in[I_NFFN]) + l * DM, hA, nullptr, nullptr, (const float*)(p->ws + WS_PART), 4);
      } else if (s == 7 && PHON(7)) {
        { EpiBf<0> E{(bf16_t*)(p->ws + WS_QB), DM}; run_gemm(cx, gl, hA, (const bf16_t*)(wl + WL_Q), T_P, DM, DM, E, cx.bid); }
        { const int nsl = 4, Ks = DM / nsl;
#pragma unroll 1
          for (int c = cx.bid; c < 16 * nsl; c += cx.G) { Ctx c2 = cx; asm volatile("" : "+v"(c2.tid));
            OneUnit S; S.valid = 1; const int un = c / nsl, sl = c % nsl; S.pm = un >> 2; S.pn = un & 3;
            pg8::Gemm g{hA + (size_t)T_P * DM + (size_t)sl * Ks, (const bf16_t*)(wl + WL_Q) + (size_t)sl * Ks, T_S, DM, Ks, DM};
            EpiStoreF32 E{(float*)(p->ws + WS_PART) + (size_t)sl * T_S * DM, DM}; pg8::gemm_phase<EpiStoreF32, OneUnit>(gl, g, S, E, c2.tid); } }
      } else if (s == 8 && PHON(8)) {
        { const int nrd = (1024 + cx.G - 1) / cx.G, rot = (cx.bid & 1) ? nrd / 2 : 0;
          for (int k_ = 0; k_ < nrd; ++k_) { const int u = cx.bid + ((k_ + rot) % nrd) * cx.G; if (u < 1024) {
              if (u < 512) { int uu = u;
                if (cx.G == 256) { const int r = u >> 8, bb = u & 255, xcd = bb & 7, j = bb >> 3; uu = ((r * 16 + xcd * 2 + (j >> 4)) << 4) | (j & 15); }
                attn_prompt_unit(p, cx, l, uu, lds); }
              else attn_sample_unit(p, cx, l, u - 512, lds); } } }
      } else if (s == 11 && PHON(11)) {
        EpiBf<1> E{(bf16_t*)(p->ws + WS_HID), DFF}; run_gemm(cx, gl, hA, (const bf16_t*)(wl + WL_UP), T_ALL, DFF, DM, E, cx.bid);
      } else if (s == 13 && PHON(13)) {
        if (l == 0) rms_rows<false, false>(cx, xres, xres + (size_t)T_P * DM, p->in[I_NMIX] + DM, hA, nullptr, nullptr, (const float*)(p->ws + WS_PART), 16);
        else rms_rows<true, false>(cx, xres, xres + (size_t)T_P * DM, p->in[I_NFINAL], nullptr, p->out + O_Y, nullptr, (const float*)(p->ws + WS_PART), 16);
      }
    }
    if (ph + 1 < ph_hi) xcd_barrier(xb, cx.tid);
  }
}

extern "C" void kernel_launch(void* const* d_in, const int* in_sizes, int n_in, void* d_out, int out_size, void* d_ws, size_t ws_size, hipStream_t stream) {
  static int grid_blocks = 0;
  if (!grid_blocks) {
    int dev = 0, cus = 0, per_cu = 0;
    (void)hipGetDevice(&dev);
    (void)hipDeviceGetAttribute(&cus, hipDeviceAttributeMultiprocessorCount, dev);
    (void)hipFuncSetAttribute((const void*)mega, hipFuncAttributeMaxDynamicSharedMemorySize, LDS_BYTES);
    (void)hipOccupancyMaxActiveBlocksPerMultiprocessor(&per_cu, (const void*)mega, NTHR, LDS_BYTES);
    if (per_cu < 1) per_cu = 1;
    grid_blocks = cus * per_cu;
    if (n_in != 47 || (size_t)out_size != O_END || ws_size < WS_END) fprintf(stderr, "kernel_launch: unexpected sizes n_in %d out %d ws %zu (need %zu)\n", n_in, out_size, ws_size, (size_t)WS_END);
  }
  Params p{};
  for (int i = 0; i < 47; ++i) p.in[i] = (const float*)d_in[i];
  p.out = (float*)d_out; p.ws = (unsigned char*)d_ws; p.ph_lo = 0; p.ph_hi = NPHASE;
  (void)hipMemsetAsync((char*)d_ws + WS_BAR, 0, XCD_BAR_WORDS * 4, stream);
  void* args[] = {&p};
  hipError_t e = hipLaunchCooperativeKernel((const void*)mega, dim3(grid_blocks), dim3(NTHR), args, LDS_BYTES, stream);
  if (e != hipSuccess) fprintf(stderr, "cooperative launch failed: %s (grid %d)\n", hipGetErrorString(e), grid_blocks);
}
```
